# Optimizing an MI355X kernel written in HIP

```python
import math
import jax
import jax.numpy as jnp
from jax import lax
import numpy as np

D_MODEL = 1024
BATCH = 4
SEQ = 4096
DEPTH = 1
DEC_BATCH = 32
DEC_SEQ = 8
PAST_LEN = 16384
PAGE_SIZE = 128

A_GROUPS = ((128, 1), (512, 4), (2048, 16))
A_HEADS = 4
A_HEAD_DIM = 128
A_QKV = len(A_GROUPS) * A_HEADS * A_HEAD_DIM
A_OUT = A_HEADS * A_HEAD_DIM
Q_BLOCK = 128
R_HEADS = 4
R_KEY_DIM = 128
R_VAL_DIM = 256
R_QK = R_HEADS * R_KEY_DIM
R_V = R_HEADS * R_VAL_DIM
R_CHUNK = 128
ROPE_BASE = 10000.0
EPS = 1e-5
NEG_INF = -1e30
DEEPNORM_ALPHA = (2 * DEPTH) ** 0.25
DEEPNORM_BETA = (8 * DEPTH) ** -0.25
SPLIT_SIZES = (A_QKV, A_QKV, A_QKV, A_OUT, R_QK, R_QK, R_V, R_V, D_MODEL, D_MODEL)
D_IN = sum(SPLIT_SIZES)
SPLIT_POINTS = tuple(int(s) for s in np.cumsum(SPLIT_SIZES)[:-1])

kernel_name = 'dilated_retention_hybrid_step'


def alibi_slopes(n):
    return jnp.exp2(-8.0 * jnp.arange(1, n + 1, dtype=jnp.float32) / n)


def rotary(x, pos):
    half = x.shape[-1] // 2
    inv = 1.0 / (ROPE_BASE ** jnp.linspace(0.0, 1.0, half, dtype=jnp.float32))
    ang = pos.astype(jnp.float32)[:, None] * inv[None, :]
    cos = jnp.cos(ang)[None, :, None, :]
    sin = jnp.sin(ang)[None, :, None, :]
    x1, x2 = x[..., :half], x[..., half:]
    return jnp.concatenate([x1 * cos - x2 * sin, x1 * sin + x2 * cos], axis=-1)


def dilated_mixture_attention(q, ext_k, ext_v, buf_lens):
    B, T, G, H, dh = q.shape
    qb = Q_BLOCK if T % Q_BLOCK == 0 else T
    n_blk = T // qb
    slopes = alibi_slopes(G * H).reshape(G, H)
    scale = dh ** -0.5

    def block(bi):
        t0 = bi * qb
        qblk = lax.dynamic_slice_in_dim(q, t0, qb, axis=1).astype(jnp.float32)
        lses, outs = [], []
        for g, (w, d) in enumerate(A_GROUPS):
            nk = w // d + 1
            dist = jnp.arange(nk, dtype=jnp.int32) * d
            idx = buf_lens[g] + t0 + jnp.arange(qb, dtype=jnp.int32)[:, None] - dist[None, :]
            valid = idx >= 0
            idx = jnp.maximum(idx, 0)
            kg = jnp.take(ext_k[g], idx, axis=1).astype(jnp.float32)
            vg = jnp.take(ext_v[g], idx, axis=1).astype(jnp.float32)
            s = (jnp.einsum('bqhd,bqkhd->bhqk', qblk[:, :, g], kg) * scale
                 - slopes[g][None, :, None, None] * dist.astype(jnp.float32)[None, None, None, :])
            s = jnp.where(valid[None, None], s, NEG_INF)
            lse = jax.nn.logsumexp(s, axis=-1)
            p = jnp.exp(s - lse[..., None])
            outs.append(jnp.einsum('bhqk,bqkhd->bqhd', p, vg))
            lses.append(lse)
        wts = jax.nn.softmax(jnp.stack(lses, axis=0), axis=0)
        return jnp.einsum('gbhq,gbqhd->bqhd', wts, jnp.stack(outs, axis=0))

    o = lax.map(block, jnp.arange(n_blk, dtype=jnp.int32))
    return o.transpose(1, 0, 2, 3, 4).reshape(B, T, H, dh)


def retention_chunkwise(q, k, v, s0):
    B, T, H, dk = q.shape
    dv = v.shape[-1]
    c = R_CHUNK if T % R_CHUNK == 0 else T
    n = T // c
    lg = jnp.log1p(-jnp.exp2(-5.0 - jnp.arange(H, dtype=jnp.float32)))
    i = jnp.arange(c, dtype=jnp.float32)
    diff = i[:, None] - i[None, :]
    causal = diff >= 0
    dmat = jnp.where(causal[None], jnp.exp(jnp.where(causal, diff, 0.0)[None] * lg[:, None, None]), 0.0)
    q_decay = jnp.exp((i[:, None] + 1.0) * lg[None, :])
    k_decay = jnp.exp((c - 1.0 - i)[:, None] * lg[None, :])
    chunk_decay = jnp.exp(c * lg)

    def to_chunks(a):
        return a.reshape(B, n, c, H, a.shape[-1]).transpose(1, 0, 2, 3, 4)

    def step(S, qkv):
        qc, kc, vc = qkv
        att = jnp.einsum('bihd,bjhd->bhij', qc, kc) * dmat[None]
        o = (jnp.einsum('bhij,bjhe->bihe', att, vc)
             + jnp.einsum('bihd,bhde->bihe', qc, S) * q_decay[None, :, :, None])
        S = (chunk_decay[None, :, None, None] * S
             + jnp.einsum('bjhd,bjhe->bhde', kc * k_decay[None, :, :, None], vc))
        return S, o

    S, o = lax.scan(step, s0, (to_chunks(q), to_chunks(k), to_chunks(v)))
    return o.transpose(1, 0, 2, 3, 4).reshape(B, T, H, dv), S


def hybrid_layer(x, pos0, bufs, s0, w_in, w_pa, w_pb, w_o, gn_g, ln_g, ln_b):
    B, T, _ = x.shape
    G = len(A_GROUPS)
    h = x @ w_in
    qa, ka, va, za, qr, kr, vr, zr, ga, gb = jnp.split(h, SPLIT_POINTS, axis=-1)
    qa = qa.reshape(B, T, G, A_HEADS, A_HEAD_DIM)
    ka = ka.reshape(B, T, G, A_HEADS, A_HEAD_DIM)
    va = va.reshape(B, T, G, A_HEADS, A_HEAD_DIM)
    ext_k, ext_v, lens, new_bufs = [], [], [], []
    for g, (w, d) in enumerate(A_GROUPS):
        kv_new = jnp.stack([ka[:, :, g], va[:, :, g]], axis=2)
        if bufs is None:
            kv_all = kv_new
            lens.append(0)
        else:
            kv_all = jnp.concatenate([bufs[g].astype(kv_new.dtype), kv_new], axis=1)
            lens.append(bufs[g].shape[1])
        ext_k.append(kv_all[:, :, 0])
        ext_v.append(kv_all[:, :, 1])
        keep = min(w, kv_all.shape[1])
        new_bufs.append(kv_all[:, kv_all.shape[1] - keep:])
    o_a = dilated_mixture_attention(qa, ext_k, ext_v, lens)
    pos = pos0 + jnp.arange(T, dtype=jnp.int32)
    qr = rotary(qr.reshape(B, T, R_HEADS, R_KEY_DIM).astype(jnp.float32), pos)
    kr = rotary(kr.reshape(B, T, R_HEADS, R_KEY_DIM).astype(jnp.float32), pos) * (R_KEY_DIM ** -0.5)
    vr = vr.reshape(B, T, R_HEADS, R_VAL_DIM).astype(jnp.float32)
    o_r, s_new = retention_chunkwise(qr, kr, vr, s0.astype(jnp.float32))
    mu = jnp.mean(o_r, axis=-1, keepdims=True)
    var = jnp.mean(jnp.square(o_r - mu), axis=-1, keepdims=True)
    o_r = ((o_r - mu) * lax.rsqrt(var + EPS)).reshape(B, T, R_V) * gn_g.astype(jnp.float32)
    y_a = (jax.nn.silu(za) * o_a.reshape(B, T, A_OUT).astype(x.dtype)) @ w_pa
    y_b = (jax.nn.silu(zr) * o_r.astype(x.dtype)) @ w_pb
    out = (jax.nn.sigmoid(ga) * y_a + jax.nn.sigmoid(gb) * y_b) @ w_o
    z = (DEEPNORM_ALPHA * x + out).astype(jnp.float32)
    zm = jnp.mean(z, axis=-1, keepdims=True)
    zv = jnp.mean(jnp.square(z - zm), axis=-1, keepdims=True)
    y = ((z - zm) * lax.rsqrt(zv + EPS) * ln_g.astype(jnp.float32) + ln_b.astype(jnp.float32)).astype(x.dtype)
    return y, new_bufs[0], new_bufs[1], new_bufs[2], s_new.astype(x.dtype)


def setup_inputs(seed: int = 0) -> dict:
    key = jax.random.key(seed)
    ks = jax.random.split(key, 16)
    f32 = jnp.float32
    x_prompt = jax.random.normal(ks[0], (BATCH, SEQ, D_MODEL), f32)
    x_sample = jax.random.normal(ks[1], (DEC_BATCH, DEC_SEQ, D_MODEL), f32)
    caches = [jax.random.normal(ks[2 + g], (DEC_BATCH, min(w, PAST_LEN), 2, A_HEADS, A_HEAD_DIM), f32)
              for g, (w, _) in enumerate(A_GROUPS)]
    state_ret = 0.5 * jax.random.normal(ks[5], (DEC_BATCH, R_HEADS, R_KEY_DIM, R_VAL_DIM), f32)
    offs = np.concatenate([[0], np.cumsum(SPLIT_SIZES)])
    col_scale = np.ones((D_IN,), np.float32)
    col_scale[offs[2]:offs[3]] = DEEPNORM_BETA
    col_scale[offs[6]:offs[7]] = DEEPNORM_BETA
    w_in = jax.random.normal(ks[6], (D_MODEL, D_IN), f32) * (D_MODEL ** -0.5) * jnp.asarray(col_scale)
    w_pa = jax.random.normal(ks[7], (A_OUT, D_MODEL), f32) * (A_OUT ** -0.5) * DEEPNORM_BETA
    w_pb = jax.random.normal(ks[8], (R_V, D_MODEL), f32) * (R_V ** -0.5) * DEEPNORM_BETA
    w_o = jax.random.normal(ks[9], (D_MODEL, D_MODEL), f32) * (D_MODEL ** -0.5) * DEEPNORM_BETA
    gn_g = 1.0 + 0.02 * jax.random.normal(ks[10], (R_V,), f32)
    ln_g = 1.0 + 0.02 * jax.random.normal(ks[11], (D_MODEL,), f32)
    ln_b = 0.02 * jax.random.normal(ks[12], (D_MODEL,), f32)
    return {'x_prompt': x_prompt, 'x_sample': x_sample,
            'cache_kv_w128': caches[0], 'cache_kv_w512': caches[1], 'cache_kv_w2048': caches[2],
            'state_ret': state_ret,
            'w_in': w_in, 'w_pa': w_pa, 'w_pb': w_pb, 'w_o': w_o,
            'gn_g': gn_g, 'ln_g': ln_g, 'ln_b': ln_b}


def reference(x_prompt, x_sample, cache_kv_w128, cache_kv_w512, cache_kv_w2048, state_ret,
              w_in, w_pa, w_pb, w_o, gn_g, ln_g, ln_b):
    y_p, x_p = x_prompt, x_prompt
    y_s, x_s = x_sample, x_sample
    for layer in range(DEPTH):
        s0_p = jnp.zeros((x_p.shape[0], R_HEADS, R_KEY_DIM, R_VAL_DIM), jnp.float32)
        y_p, kv128_p, kv512_p, kv2048_p, ret_p = hybrid_layer(
            x_p, 0, None, s0_p, w_in, w_pa, w_pb, w_o, gn_g, ln_g, ln_b)
        y_s, kv128_s, kv512_s, kv2048_s, ret_s = hybrid_layer(
            x_s, PAST_LEN, (cache_kv_w128, cache_kv_w512, cache_kv_w2048), state_ret,
            w_in, w_pa, w_pb, w_o, gn_g, ln_g, ln_b)
        x_p, x_s = y_p, y_s
    return (y_p, y_s, kv128_p, kv512_p, kv2048_p, ret_p, kv128_s, kv512_s, kv2048_s, ret_s)
```

```cpp
#include <hip/hip_runtime.h>
#include <hip/hip_cooperative_groups.h>
#include <cstdio>
#include <cmath>
namespace cg = cooperative_groups;
#define MULTI 0
namespace pg8 {
#define PG8_LAS __attribute__((address_space(3)))
typedef unsigned short bf16_t;
typedef short bf16x8 __attribute__((ext_vector_type(8)));
typedef float f32x4 __attribute__((ext_vector_type(4)));
typedef unsigned u32x4 __attribute__((ext_vector_type(4)));
constexpr int BM = 256, BK = 64, HALF = 128, HTB = HALF * BK * 2  , STAGE_BYTES = 8 * HTB, NXCD = 8, WGM = 8;

__host__ __device__ __forceinline__ int lds_byte(int r, int c) { const int st = (r >> 4) * 2 + (c >> 5), rr = r & 15, cc = c & 31, ob = rr * 64 + cc * 2; return st * 1024 + (ob ^ (((ob >> 9) & 1) << 5)); }
__host__ __device__ __forceinline__ void stage_rc(int b, int& R, int& C) { const int st = b / 1024, sb = b % 1024, swz = sb ^ (((sb >> 9) & 1) << 5); R = (st >> 1) * 16 + swz / 64; C = (st & 1) * 32 + (swz % 64) / 2; }
__host__ __device__ __forceinline__ int perm32(int rho) { const int n = rho >> 4, i = rho & 15; return 8 * (i >> 2) + 4 * n + (i & 3); }

struct Unit { int pm, pn; };
struct Gemm { const bf16_t* A; const bf16_t* Bt; int M, N, K; };

struct StaticOrder {
    int nM, nN, nwg, G, c;
    __host__ __device__ void init(int M, int N, int G_, int c_) { nM = M / BM; nN = N / BM; nwg = nM * nN; G = G_; c = c_; }
    __host__ __device__ bool next(int i, Unit& u) const {
        const long L = (long)i * G + c; if (L >= nwg) return false;
        int wgid = (int)L; { const int q = nwg / NXCD, r = nwg % NXCD, xcd = wgid % NXCD, off = wgid / NXCD; wgid = (xcd < r ? xcd * (q + 1) : r * (q + 1) + (xcd - r) * q) + off; }
        const int nig = WGM * nN, gid = wgid / nig, fm = gid * WGM, gsz = (nM - fm) < WGM ? (nM - fm) : WGM;
        u.pm = fm + ((wgid % nig) % gsz); u.pn = (wgid % nig) / gsz; return true;
    }
    __device__ __forceinline__ void a_ready(const Unit&) const {}
    __device__ __forceinline__ void done(const Unit&) const {}
};
__device__ __forceinline__ unsigned cvt_pk_bf16(float lo, float hi) { unsigned r; asm volatile("v_cvt_pk_bf16_f32 %0, %1, %2" : "=v"(r) : "v"(lo), "v"(hi)); return r; }
template <class Epi, class Sched, bool STAMP = false>
__device__ __forceinline__ void gemm_phase(PG8_LAS unsigned char* lds, const Gemm g, const Sched& S, const Epi& E, unsigned long long* stamps) {
    const int tid = threadIdx.x, wid = __builtin_amdgcn_readfirstlane(tid >> 6), lane = tid & 63, wr = wid >> 2, wc = wid & 3, fr = lane & 15, fq = lane >> 4;
    const int K = g.K, nt = K / BK;
    int ts_lo = 0, ts_hi = 0, nts = 0; const unsigned long long rt_entry = STAMP ? (unsigned long long)wall_clock64() : 0ull;
#define PG8_STAMP() do { if (STAMP && wid == 0 && nts < 64) { const unsigned long long _c = (unsigned long long)clock64(); \
        ts_lo = (lane == nts) ? (int)(unsigned)_c : ts_lo; ts_hi = (lane == nts) ? (int)(unsigned)(_c >> 32) : ts_hi; ++nts; } } while (0)
    PG8_STAMP();
    unsigned voffA[2], voffB[2];
#pragma unroll
    for (int i = 0; i < 2; ++i) { int R, C; stage_rc(tid * 16 + i * 8192, R, C); const int Rb = Epi::PERM ? ((R & ~31) + perm32(R & 31)) : R;
        voffA[i] = (unsigned)(R * K + C) * 2u; voffB[i] = (unsigned)(Rb * K + C) * 2u; }
    const size_t kstep = (size_t)(BK * 2);
    const size_t hstep = (size_t)HALF * K * 2;
    const size_t tstep = 2 * hstep;
    const unsigned ldsw = (unsigned)wid * 1024u;
    const int aoff = lds_byte(wr * 64 + fr, fq * 8), boff = lds_byte(wc * 32 + fr, fq * 8);
#define PG8_SA(b, h) (((b) * 2 + (h)) * HTB)
#define PG8_SB(b, h) ((4 + (b) * 2 + (h)) * HTB)
#define PG8_STAGE(bufoff, gbase, voff) do { _Pragma("unroll") for (int _i = 0; _i < 2; ++_i) \
        __builtin_amdgcn_global_load_lds((const unsigned*)((const char*)(gbase) + (voff)[_i]), (PG8_LAS unsigned*)(lds + (bufoff) + ldsw + _i * 8192), 16, 0, 0); } while (0)
#define PG8_LDA(dst, b, h) do { _Pragma("unroll") for (int m = 0; m < 4; ++m) _Pragma("unroll") for (int k = 0; k < 2; ++k) dst[m][k] = *(const PG8_LAS bf16x8*)(lds + PG8_SA(b, h) + aoff + m * 2048 + k * 1024); } while (0)
#define PG8_LDB(dst, b, h) do { _Pragma("unroll") for (int n = 0; n < 2; ++n) _Pragma("unroll") for (int k = 0; k < 2; ++k) dst[n][k] = *(const PG8_LAS bf16x8*)(lds + PG8_SB(b, h) + boff + n * 2048 + k * 1024); } while (0)
#define PG8_MMA(ai, bj, At, Bt) do { __builtin_amdgcn_s_setprio(1); _Pragma("unroll") for (int m = 0; m < 4; ++m) _Pragma("unroll") for (int n = 0; n < 2; ++n) _Pragma("unroll") for (int k = 0; k < 2; ++k) \
        acc[ai][bj][m][n] = __builtin_amdgcn_mfma_f32_16x16x32_bf16(Bt[n][k], At[m][k], acc[ai][bj][m][n], 0, 0, 0); __builtin_amdgcn_s_setprio(0); } while (0)
#define PG8_WAIT_V(n) asm volatile("s_waitcnt vmcnt(" #n ")" ::: "memory")
#define PG8_WAIT_L(n) asm volatile("s_waitcnt lgkmcnt(" #n ")" ::: "memory")
#define PG8_BAR __builtin_amdgcn_s_barrier()
#define PG8_SCHED __builtin_amdgcn_sched_barrier(0)
    Unit cur, nxt; int ui = 0;
    if (!S.next(0, cur)) return;
    f32x4 acc[2][2][4][2];
#pragma unroll
    for (int a = 0; a < 2; ++a)
#pragma unroll
        for (int b = 0; b < 2; ++b)
#pragma unroll
            for (int m = 0; m < 4; ++m)
#pragma unroll
                for (int n = 0; n < 2; ++n) acc[a][b][m][n] = (f32x4){0.f, 0.f, 0.f, 0.f};
    bf16x8 At[4][2], B0[2][2], B1[2][2];
    const char* cA = (const char*)g.A + (size_t)cur.pm * tstep; const char* cB = (const char*)g.Bt + (size_t)cur.pn * tstep;
    S.a_ready(cur);
    PG8_STAGE(PG8_SB(0, 0), cB, voffB); PG8_STAGE(PG8_SA(0, 0), cA, voffA); PG8_STAGE(PG8_SB(0, 1), cB + hstep, voffB); PG8_STAGE(PG8_SA(0, 1), cA + hstep, voffA);
    if (wr == 1) PG8_BAR;
    PG8_WAIT_V(4); PG8_BAR;
    PG8_STAGE(PG8_SB(1, 0), cB + kstep, voffB); PG8_STAGE(PG8_SA(1, 0), cA + kstep, voffA); PG8_STAGE(PG8_SB(1, 1), cB + hstep + kstep, voffB);
    PG8_WAIT_V(6); PG8_BAR;
    PG8_STAMP();
    for (;;) {
        const bool has_next = S.next(ui + 1, nxt);
        const char* nA = has_next ? (const char*)g.A + (size_t)nxt.pm * tstep : cA; const char* nB = has_next ? (const char*)g.Bt + (size_t)nxt.pn * tstep : cB;
        for (int t = 0; t < nt; t += 2) {
            const bool last = (t == nt - 2);
            const char* a1 = cA + (size_t)(t + 1) * kstep;
            const char* a2 = last ? nA : cA + (size_t)(t + 2) * kstep; const char* b2 = last ? nB : cB + (size_t)(t + 2) * kstep;
            const char* a3 = a2 + kstep; const char* b3 = b2 + kstep;
            if (last && has_next) S.a_ready(nxt);
            PG8_LDB(B0, 0, 0); PG8_SCHED; PG8_LDA(At, 0, 0); PG8_STAGE(PG8_SA(1, 1), a1 + hstep, voffA);
            PG8_WAIT_L(8); PG8_BAR; PG8_WAIT_L(0); PG8_MMA(0, 0, At, B0); PG8_BAR; PG8_SCHED;
            PG8_LDB(B1, 0, 1); PG8_STAGE(PG8_SB(0, 0), b2, voffB);
            PG8_BAR; PG8_WAIT_L(0); PG8_MMA(0, 1, At, B1); PG8_BAR;
            PG8_LDA(At, 0, 1); PG8_STAGE(PG8_SA(0, 0), a2, voffA);
            PG8_BAR; PG8_WAIT_L(0); PG8_MMA(1, 0, At, B0); PG8_BAR; PG8_SCHED;
            PG8_STAGE(PG8_SB(0, 1), b2 + hstep, voffB);
            PG8_WAIT_V(6); PG8_BAR; PG8_MMA(1, 1, At, B1); PG8_BAR;
            PG8_LDB(B0, 1, 0); PG8_SCHED; PG8_LDA(At, 1, 0); PG8_STAGE(PG8_SA(0, 1), a2 + hstep, voffA);
            PG8_WAIT_L(8); PG8_BAR; PG8_WAIT_L(0); PG8_MMA(0, 0, At, B0); PG8_BAR; PG8_SCHED;
            PG8_LDB(B1, 1, 1); PG8_STAGE(PG8_SB(1, 0), b3, voffB);
            PG8_BAR; PG8_WAIT_L(0); PG8_MMA(0, 1, At, B1); PG8_BAR;
            PG8_LDA(At, 1, 1); PG8_STAGE(PG8_SA(1, 0), a3, voffA);
            PG8_BAR; PG8_WAIT_L(0); PG8_MMA(1, 0, At, B0); PG8_BAR; PG8_SCHED;
            PG8_STAGE(PG8_SB(1, 1), b3 + hstep, voffB);
            PG8_WAIT_V(6); PG8_BAR; PG8_MMA(1, 1, At, B1); PG8_BAR;
        }
        PG8_STAMP();
        if constexpr (!Epi::AFTER_DRAIN) { E(acc, cur, wr, wc, fr, fq); S.done(cur); }
        PG8_STAMP();
        if (!has_next) break;
#pragma unroll
        for (int a = 0; a < 2; ++a)
#pragma unroll
            for (int b = 0; b < 2; ++b)
#pragma unroll
                for (int m = 0; m < 4; ++m)
#pragma unroll
                    for (int n = 0; n < 2; ++n) acc[a][b][m][n] = (f32x4){0.f, 0.f, 0.f, 0.f};
        cur = nxt; cA = nA; cB = nB; ++ui;
    }
    PG8_WAIT_V(0);
    if (wr == 0) PG8_BAR;
    PG8_BAR;
    if constexpr (Epi::AFTER_DRAIN) { E.fused(acc, cur, wr, wc, fr, fq, lds, wid, lane); S.done(cur); }
    PG8_STAMP();
    if (STAMP && wid == 0) { stamps[lane] = lane < nts ? (((unsigned long long)(unsigned)ts_hi << 32) | (unsigned)ts_lo) : 0ull;
        if (lane == 62) stamps[62] = rt_entry; if (lane == 63) stamps[63] = (unsigned long long)wall_clock64(); }
#undef PG8_STAMP
#undef PG8_SA
#undef PG8_SB
#undef PG8_STAGE
#undef PG8_LDA
#undef PG8_LDB
#undef PG8_MMA
#undef PG8_WAIT_V
#undef PG8_WAIT_L
#undef PG8_BAR
#undef PG8_SCHED
}
}

using pg8::bf16_t; using pg8::bf16x8; using pg8::f32x4; using pg8::u32x4;
typedef float f32x16 __attribute__((ext_vector_type(16)));
typedef short s16x4 __attribute__((ext_vector_type(4)));
typedef unsigned u32x2 __attribute__((ext_vector_type(2)));
typedef float f32x2v __attribute__((ext_vector_type(2)));
#define LAS __attribute__((address_space(3)))

constexpr int NP = 16384, NTOK = 16640, DM = 1024, DIN = 10240;
constexpr int C_QA = 0, C_KA = 1536, C_VA = 3072, C_ZA = 4608, C_QR = 5120, C_KR = 5632, C_VR = 6144, C_ZR = 7168, C_GA = 8192, C_GB = 9216;
constexpr size_t O_YP = 0, O_KVP0 = 17039360, O_KVP1 = 17563648, O_KVP2 = 19660800, O_RETP = 28049408,
                 O_KVS0 = 28573696, O_KVS1 = 32768000, O_KVS2 = 49545216, O_RETS = 116654080, O_END = 120848384;
constexpr int LDS_BYTES = 131072 + 4096;
constexpr float LOG2E = 1.4426950408889634f, LN2 = 0.6931471805599453f;

struct Params {
    const float *x_p, *x_s, *c0, *c1, *c2, *state, *w_in, *w_pa, *w_pb, *w_o, *gn_g, *ln_g, *ln_b;
    float* out;
    bf16_t *xb, *winT, *wpaT, *wpbT, *woT, *hb, *og, *ain, *bin, *mb, *ST;
    float *lse, *UT, *mpart, *invtab;
    float inv[64];
};

__device__ __forceinline__ unsigned pk(float lo, float hi) { return pg8::cvt_pk_bf16(lo, hi); }
__device__ __forceinline__ float bflo(unsigned u) { return __uint_as_float(u << 16); }
__device__ __forceinline__ float bfhi(unsigned u) { return __uint_as_float(u & 0xffff0000u); }
__device__ __forceinline__ float bf2f(bf16_t b) { return __uint_as_float(((unsigned)b) << 16); }
__device__ __forceinline__ unsigned off_b(unsigned row, unsigned ch) { return 256u * row + 16u * (ch ^ (((row & 3) << 2) | ((row >> 2) & 3))); }
__device__ __forceinline__ float fexp2(float x) { return __builtin_amdgcn_exp2f(x); }
__device__ __forceinline__ float frcp(float x) { return __builtin_amdgcn_rcpf(x); }
__device__ __forceinline__ float sigm(float x) { return frcp(1.0f + fexp2(-x * LOG2E)); }
__device__ __forceinline__ float lg2gamma(int hh) { return log1pf(-exp2f(-5.0f - (float)hh)) * LOG2E; }
__device__ __forceinline__ bf16x8 tr2(LAS unsigned char* a0, LAS unsigned char* a1) {
    s16x4 x = __builtin_amdgcn_ds_read_tr16_b64_v4i16((LAS s16x4*)a0), y = __builtin_amdgcn_ds_read_tr16_b64_v4i16((LAS s16x4*)a1);
    bf16x8 r; r[0] = x[0]; r[1] = x[1]; r[2] = x[2]; r[3] = x[3]; r[4] = y[0]; r[5] = y[1]; r[6] = y[2]; r[7] = y[3]; return r;
}
__device__ __forceinline__ bf16x8 pack8(float a, float b, float c, float d, float e, float f, float g, float h) {
    u32x4 u = {pk(a, b), pk(c, d), pk(e, f), pk(g, h)}; return __builtin_bit_cast(bf16x8, u);
}
__device__ __forceinline__ f32x16 zero16() { f32x16 z; for (int i = 0; i < 16; ++i) z[i] = 0.f; return z; }
__device__ __forceinline__ float wave_sum(float v) { for (int o = 32; o > 0; o >>= 1) v += __shfl_xor(v, o); return v; }
__device__ __forceinline__ float wave_max(float v) { for (int o = 32; o > 0; o >>= 1) v = fmaxf(v, __shfl_xor(v, o)); return v; }

__device__ __forceinline__ void phase_prep(const Params& p, LAS unsigned char* lds) {
    const int tid = threadIdx.x, nb = gridDim.x, bid = blockIdx.x;
    const size_t gtid = (size_t)bid * 512 + tid, gstride = (size_t)nb * 512;
    if (bid == 0 && tid == 0) {
#pragma unroll
        for (int i = 0; i < 64; ++i) p.invtab[i] = p.inv[i];
    }
    LAS float* tile = (LAS float*)lds;
    for (int t = bid; t < 3200; t += nb) {
        const float* W; bf16_t* Wt; int K, N, kt, nt; bool perm = false;
        if (t < 2560) { W = p.w_in; Wt = p.winT; K = 1024; N = 10240; kt = t & 15; nt = t >> 4; perm = (nt * 64 >= C_QR && nt * 64 < C_VR); }
        else if (t < 2688) { const int t2 = t - 2560; W = p.w_pa; Wt = p.wpaT; K = 512; N = 1024; kt = t2 & 7; nt = t2 >> 3; }
        else if (t < 2944) { const int t2 = t - 2688; W = p.w_pb; Wt = p.wpbT; K = 1024; N = 1024; kt = t2 & 15; nt = t2 >> 4; }
        else { const int t2 = t - 2944; W = p.w_o; Wt = p.woT; K = 1024; N = 1024; kt = t2 & 15; nt = t2 >> 4; }
        {
            const int nn = tid & 63; int n = nt * 64 + nn;
            if (perm) { const int u = n & 127; n = (n & ~127) + (u >> 1) + 64 * (u & 1); }
#pragma unroll
            for (int ps = 0; ps < 8; ++ps) { const int kr = (tid >> 6) + 8 * ps; tile[kr * 65 + nn] = W[(size_t)(kt * 64 + kr) * N + n]; }
        }
        __syncthreads();
        {
            const int n = tid >> 3, k8 = (tid & 7) * 8;
            float v[8];
#pragma unroll
            for (int i = 0; i < 8; ++i) v[i] = tile[(k8 + i) * 65 + n];
            u32x4 o = {pk(v[0], v[1]), pk(v[2], v[3]), pk(v[4], v[5]), pk(v[6], v[7])};
            *(u32x4*)(Wt + (size_t)(nt * 64 + n) * K + kt * 64 + k8) = o;
        }
        __syncthreads();
    }
    for (size_t i = gtid; i < (size_t)NTOK * 128; i += gstride) {
        const size_t e = i * 8;
        const float* src = e < (size_t)NP * DM ? p.x_p + e : p.x_s + (e - (size_t)NP * DM);
        const f32x4 a = *(const f32x4*)src, b = *(const f32x4*)(src + 4);
        u32x4 o = {pk(a[0], a[1]), pk(a[2], a[3]), pk(b[0], b[1]), pk(b[2], b[3])};
        *(u32x4*)(p.xb + e) = o;
    }
#pragma unroll
    for (int g = 0; g < 3; ++g) {
        const int L = 128 << (2 * g);
        const float* src0 = g == 0 ? p.c0 : (g == 1 ? p.c1 : p.c2);
        float* dst0 = p.out + (g == 0 ? O_KVS0 : (g == 1 ? O_KVS1 : O_KVS2));
        const size_t perb = (size_t)(L - 8) * 256, total = perb * 32;
        for (size_t i = gtid; i < total; i += gstride) {
            const size_t b = i / perb, r = i - b * perb;
            const f32x4 v = __builtin_nontemporal_load((const f32x4*)(src0 + ((size_t)b * L + 8) * 1024 + r * 4));
            __builtin_nontemporal_store(v, (f32x4*)(dst0 + (size_t)b * L * 1024 + r * 4));
        }
    }
}

__device__ __forceinline__ void sincos_rev(float ang, float& s, float& c) {
    double rv = (double)ang * 0.15915494309189535; rv -= __builtin_rint(rv);
    const float f = (float)rv; s = __builtin_amdgcn_sinf(f); c = __builtin_amdgcn_cosf(f);
}
struct Epi1 {
    static constexpr bool PERM = true, AFTER_DRAIN = false;
    bf16_t* hb; float* out; const float* invtab;
    __device__ __forceinline__ void operator()(const f32x4 (&acc)[2][2][4][2], const pg8::Unit& u, int wr, int wc, int fr, int fq) const {
        const int pn = u.pn;
        const int row0 = u.pm * 256 + wr * 64 + fr, colb = pn * 256 + wc * 32 + 8 * fq;
        if (pn >= 20 && pn < 24) {
            const float ksc = pn >= 22 ? 0.08838834764831845f : 1.0f;
#pragma unroll
            for (int ai = 0; ai < 2; ++ai)
#pragma unroll
                for (int m = 0; m < 4; ++m) {
                    const int row = row0 + ai * 128 + m * 16; bf16_t* rowp = hb + (size_t)row * DIN;
                    const float pos = (float)(row < NP ? (row & 4095) : 16384 + ((row - NP) & 7));
#pragma unroll
                    for (int bj = 0; bj < 2; ++bj) {
                        const int col = colb + bj * 128, hbase = col & ~127, i0 = (col & 127) >> 1;
                        const f32x4 iv = *(const f32x4*)(invtab + i0);
                        const f32x4 v0 = acc[ai][bj][m][0], v1 = acc[ai][bj][m][1];
                        const float x1[4] = {v0[0], v0[2], v1[0], v1[2]}, x2[4] = {v0[1], v0[3], v1[1], v1[3]};
                        float y1[4], y2[4];
#pragma unroll
                        for (int ii = 0; ii < 4; ++ii) { float s, c; sincos_rev(pos * iv[ii], s, c); y1[ii] = (x1[ii] * c - x2[ii] * s) * ksc; y2[ii] = (x1[ii] * s + x2[ii] * c) * ksc; }
                        u32x2 o1 = {pk(y1[0], y1[1]), pk(y1[2], y1[3])}, o2 = {pk(y2[0], y2[1]), pk(y2[2], y2[3])};
                        *(u32x2*)(rowp + hbase + i0) = o1; *(u32x2*)(rowp + hbase + 64 + i0) = o2;
                    }
                }
            return;
        }
        const int type = pn < 6 ? 0 : (pn < 18 ? 1 : (pn < 20 ? 2 : (pn < 28 ? 4 : (pn < 32 ? 2 : 5))));
#pragma unroll
        for (int ai = 0; ai < 2; ++ai)
#pragma unroll
            for (int m = 0; m < 4; ++m) {
                const int row = row0 + ai * 128 + m * 16; bf16_t* rowp = hb + (size_t)row * DIN;
#pragma unroll
                for (int bj = 0; bj < 2; ++bj) {
                    const int col = colb + bj * 128;
                    f32x4 v0 = acc[ai][bj][m][0], v1 = acc[ai][bj][m][1];
                    if (type == 0) { v0 *= 0.08838834764831845f * LOG2E; v1 *= 0.08838834764831845f * LOG2E; }
                    else if (type == 1) {
                        const int seg = pn - 6, kv = seg >= 6 ? 1 : 0, s6 = seg - 6 * kv, g = s6 >> 1, hh = (s6 & 1) * 2 + bj;
                        const int W = 128 << (2 * g), dcol = wc * 32 + 8 * fq;
                        float* dst = nullptr;
                        if (row < NP) { const int b = row >> 12, t = row & 4095, r = t - (4096 - W);
                            if (r >= 0) dst = out + (g == 0 ? O_KVP0 : (g == 1 ? O_KVP1 : O_KVP2)) + ((size_t)(b * W + r) * 2 + kv) * 512 + hh * 128 + dcol; }
                        else { const int rs = row - NP, b = rs >> 3, t = rs & 7, r = W - 8 + t;
                            dst = out + (g == 0 ? O_KVS0 : (g == 1 ? O_KVS1 : O_KVS2)) + ((size_t)(b * W + r) * 2 + kv) * 512 + hh * 128 + dcol; }
                        if (dst) { *(f32x4*)dst = v0; *(f32x4*)(dst + 4) = v1; }
                    }
                    else if (type == 2) {
#pragma unroll
                        for (int k = 0; k < 4; ++k) { v0[k] *= sigm(v0[k]); v1[k] *= sigm(v1[k]); }
                    }
                    else if (type == 5) {
#pragma unroll
                        for (int k = 0; k < 4; ++k) { v0[k] = sigm(v0[k]); v1[k] = sigm(v1[k]); }
                    }
                    u32x4 o = {pk(v0[0], v0[1]), pk(v0[2], v0[3]), pk(v1[0], v1[1]), pk(v1[2], v1[3])};
                    *(u32x4*)(rowp + col) = o;
                }
            }
    }
};
__device__ __forceinline__ void phase_gemm1(const Params& p, LAS unsigned char* lds) {
    pg8::StaticOrder S; S.init(NTOK, DIN, (int)gridDim.x, (int)blockIdx.x);
    pg8::Gemm g{p.xb, p.winT, NTOK, DIN, DM};
    Epi1 E{p.hb, p.out, p.invtab};
    pg8::gemm_phase<Epi1, pg8::StaticOrder, false>(lds, g, S, E, nullptr);
}

__device__ __forceinline__ void attn_prompt_item(const Params& p, LAS unsigned char* lds, int item) {
    int tid_ = threadIdx.x; asm volatile("" : "+v"(tid_));
    const int tid = tid_, lane = tid & 63, w = __builtin_amdgcn_readfirstlane(tid >> 6), r = lane & 31, h2 = lane >> 5;
    const int g = item >> 8, rem = item & 255, b = rem >> 6, hh = (rem >> 4) & 3, sub = rem & 15;
    const int dl = 2 * g, d = 1 << dl, rho = sub & (d - 1), qb = sub >> dl;
    const int ibase = qb * 256 - 128;
    const bf16_t* hbB = p.hb + (size_t)b * 4096 * DIN;
    const int colK = C_KA + g * 512 + hh * 128, colV = C_VA + g * 512 + hh * 128, colQ = C_QA + g * 512 + hh * 128;
#pragma unroll
    for (int k = 0; k < 12; ++k) {
        const int idx = tid + 512 * k, row = idx >> 4, ch = idx & 15, i = ibase + row;
        u32x4 v = {0u, 0u, 0u, 0u};
        if (i >= 0) v = *(const u32x4*)(hbB + (size_t)(rho + (i << dl)) * DIN + colK + ch * 8);
        *(LAS u32x4*)(lds + off_b(row, ch)) = v;
    }
    __syncthreads();
    const int i0w = qb * 256 + 32 * w;
    const int tokq = rho + ((i0w + r) << dl);
    bf16x8 qf[8];
    { const bf16_t* qrow = hbB + (size_t)tokq * DIN + colQ + 8 * h2;
#pragma unroll
      for (int s = 0; s < 8; ++s) qf[s] = *(const bf16x8*)(qrow + 16 * s); }
    f32x16 sacc[5];
    LAS unsigned char* krd[8];
    { const unsigned fr_ = ((r & 3) << 2) | ((r >> 2) & 3);
#pragma unroll
      for (int s = 0; s < 8; ++s) krd[s] = lds + 256 * (32 * w + r) + 16 * ((unsigned)(2 * s + h2) ^ fr_); }
#pragma unroll
    for (int kt = 0; kt < 5; ++kt) {
        sacc[kt] = zero16();
#pragma unroll
        for (int s = 0; s < 8; ++s) {
            const bf16x8 kf = *(const LAS bf16x8*)(krd[s] + 8192 * kt);
            sacc[kt] = __builtin_amdgcn_mfma_f32_32x32x16_bf16(kf, qf[s], sacc[kt], 0, 0, 0);
        }
    }
    const float slope2 = exp2f(-8.0f * (float)(4 * g + hh + 1) / 12.0f) * LOG2E * (float)d;
    float mx = -3.0e38f;
#pragma unroll
    for (int kt = 0; kt < 5; ++kt)
#pragma unroll
        for (int rg = 0; rg < 16; ++rg) {
            const int kidx = 32 * kt + (rg & 3) + 8 * (rg >> 2) + 4 * h2, ds = r + 128 - kidx;
            const bool valid = ds >= 0 && ds <= 128 && (i0w - 128 + kidx) >= 0;
            const float s = valid ? sacc[kt][rg] - slope2 * (float)ds : -1.0e30f;
            sacc[kt][rg] = s; mx = fmaxf(mx, s);
        }
    mx = fmaxf(mx, __shfl_xor(mx, 32));
    float l = 0.f;
#pragma unroll
    for (int kt = 0; kt < 5; ++kt)
#pragma unroll
        for (int rg = 0; rg < 16; ++rg) { const float pv = fexp2(sacc[kt][rg] - mx); sacc[kt][rg] = pv; l += pv; }
    l += __shfl_xor(l, 32);
    bf16x8 pf[5][2];
#pragma unroll
    for (int kt = 0; kt < 5; ++kt)
#pragma unroll
        for (int s2 = 0; s2 < 2; ++s2)
            pf[kt][s2] = pack8(sacc[kt][8 * s2], sacc[kt][8 * s2 + 1], sacc[kt][8 * s2 + 2], sacc[kt][8 * s2 + 3], sacc[kt][8 * s2 + 4], sacc[kt][8 * s2 + 5], sacc[kt][8 * s2 + 6], sacc[kt][8 * s2 + 7]);
    __syncthreads();
#pragma unroll
    for (int k = 0; k < 12; ++k) {
        const int idx = tid + 512 * k, row = idx >> 4, ch = idx & 15, i = ibase + row;
        u32x4 v = {0u, 0u, 0u, 0u};
        if (i >= 0) v = *(const u32x4*)(hbB + (size_t)(rho + (i << dl)) * DIN + colV + ch * 8);
        *(LAS u32x4*)(lds + off_b(row, ch)) = v;
    }
    __syncthreads();
    const int blk = (lane >> 4) & 1, q4 = (lane & 15) >> 2, p4 = lane & 3;
    f32x16 oacc[4];
    LAS unsigned char* vrd[4][2];
#pragma unroll
    for (int c = 0; c < 4; ++c)
#pragma unroll
        for (int t = 0; t < 2; ++t) { const unsigned f_ = ((q4 & 3) << 2) | ((h2 + 2 * t) & 3);
            vrd[c][t] = lds + 256 * (32 * w + 4 * h2 + q4 + 8 * t) + 16 * ((unsigned)(4 * c + 2 * blk + (p4 >> 1)) ^ f_) + 8 * (p4 & 1); }
#pragma unroll
    for (int c = 0; c < 4; ++c) {
        oacc[c] = zero16();
#pragma unroll
        for (int kt = 0; kt < 5; ++kt)
#pragma unroll
            for (int s2 = 0; s2 < 2; ++s2) {
                const bf16x8 vf = tr2(vrd[c][0] + 256 * (32 * kt + 16 * s2), vrd[c][1] + 256 * (32 * kt + 16 * s2));
                oacc[c] = __builtin_amdgcn_mfma_f32_32x32x16_bf16(vf, pf[kt][s2], oacc[c], 0, 0, 0);
            }
    }
    const float rl = 1.0f / l;
    const int tok = b * 4096 + tokq;
    bf16_t* orow = p.og + ((size_t)g * NTOK + tok) * 512 + hh * 128;
#pragma unroll
    for (int c = 0; c < 4; ++c)
#pragma unroll
        for (int i4 = 0; i4 < 4; ++i4) {
            u32x2 o = {pk(oacc[c][4 * i4] * rl, oacc[c][4 * i4 + 1] * rl), pk(oacc[c][4 * i4 + 2] * rl, oacc[c][4 * i4 + 3] * rl)};
            *(u32x2*)(orow + 32 * c + 8 * i4 + 4 * h2) = o;
        }
    if (h2 == 0) p.lse[((size_t)g * NTOK + tok) * 4 + hh] = (mx + __log2f(l)) * LN2;
    __syncthreads();
}

__device__ __forceinline__ void attn_sample_task(const Params& p, LAS float* wl, int task) {
    int tid_ = threadIdx.x; asm volatile("" : "+v"(tid_));
    const int lane = tid_ & 63;
    const int t = task & 7, g = (task >> 3) % 3, bh = task / 24, hh = bh & 3, b = bh >> 2;
    const int dl = 2 * g, L = 128 << dl;
    const int tok = NP + b * 8 + t;
    const float* cbase = (g == 0 ? p.c0 : (g == 1 ? p.c1 : p.c2)) + (size_t)b * L * 1024 + hh * 128;
    const float* nbase = p.out + (g == 0 ? O_KVS0 : (g == 1 ? O_KVS1 : O_KVS2)) + (size_t)b * L * 1024 + hh * 128;
    { const unsigned u = *(const unsigned*)(p.hb + (size_t)tok * DIN + C_QA + g * 512 + hh * 128 + 2 * lane); wl[2 * lane] = bflo(u); wl[2 * lane + 1] = bfhi(u); }
    __builtin_amdgcn_fence(__ATOMIC_ACQ_REL, "workgroup"); __builtin_amdgcn_wave_barrier();
    const float slope2 = exp2f(-8.0f * (float)(4 * g + hh + 1) / 12.0f) * LOG2E * (float)(1 << dl);
    float sc[3];
#pragma unroll
    for (int rnd = 0; rnd < 3; ++rnd) {
        const int j = lane + 64 * rnd; sc[rnd] = -1.0e30f;
        if (j <= 128) {
            const int pos = L + t - (j << dl);
            const float* kr = pos < L ? cbase + (size_t)pos * 1024 : nbase + (size_t)(pos - 8) * 1024;
            float a = 0.f;
#pragma unroll 8
            for (int k4 = 0; k4 < 32; ++k4) { const f32x4 kv = *(const f32x4*)(kr + 4 * k4); const f32x4 qv = *(const LAS f32x4*)(wl + 4 * k4); a += kv[0] * qv[0] + kv[1] * qv[1] + kv[2] * qv[2] + kv[3] * qv[3]; }
            sc[rnd] = a - slope2 * (float)j;
        }
    }
    const float mx = wave_max(fmaxf(sc[0], fmaxf(sc[1], sc[2])));
    float pe[3]; float l = 0.f;
#pragma unroll
    for (int rnd = 0; rnd < 3; ++rnd) { pe[rnd] = fexp2(sc[rnd] - mx); l += pe[rnd]; }
    l = wave_sum(l);
    const float rl = 1.0f / l;
#pragma unroll
    for (int rnd = 0; rnd < 3; ++rnd) { const int j = lane + 64 * rnd; if (j <= 128) wl[128 + j] = pe[rnd] * rl; }
    __builtin_amdgcn_fence(__ATOMIC_ACQ_REL, "workgroup"); __builtin_amdgcn_wave_barrier();
    float o0 = 0.f, o1 = 0.f;
#pragma unroll 4
    for (int j = 0; j <= 128; ++j) {
        const int pos = L + t - (j << dl);
        const float* vr = (pos < L ? cbase + (size_t)pos * 1024 : nbase + (size_t)(pos - 8) * 1024) + 512;
        const f32x2v v = *(const f32x2v*)(vr + 2 * lane); const float pj = wl[128 + j];
        o0 += pj * v[0]; o1 += pj * v[1];
    }
    *(unsigned*)(p.og + ((size_t)g * NTOK + tok) * 512 + hh * 128 + 2 * lane) = pk(o0, o1);
    if (lane == 0) p.lse[((size_t)g * NTOK + tok) * 4 + hh] = (mx + __log2f(l)) * LN2;
    __builtin_amdgcn_fence(__ATOMIC_ACQ_REL, "workgroup"); __builtin_amdgcn_wave_barrier();
}

__device__ __forceinline__ void ret_u_item(const Params& p, LAS unsigned char* lds, int item) {
    int tid_ = threadIdx.x; asm volatile("" : "+v"(tid_));
    const int tid = tid_, lane = tid & 63, w = __builtin_amdgcn_readfirstlane(tid >> 6), r = lane & 31, h2 = lane >> 5;
    const int hh = item & 3, c = (item >> 2) & 31, b = item >> 7;
    const int tok0 = b * 4096 + c * 128;
    const float lg = lg2gamma(hh);
    const bf16_t* hb0 = p.hb + (size_t)tok0 * DIN;
#pragma unroll
    for (int k = 0; k < 4; ++k) {
        const int idx = tid + 512 * k, row = idx >> 4, ch = idx & 15;
        const u32x4 v = *(const u32x4*)(hb0 + (size_t)row * DIN + C_KR + hh * 128 + ch * 8);
        const float kd = fexp2(lg * (float)(127 - row));
        u32x4 o;
#pragma unroll
        for (int q = 0; q < 4; ++q) o[q] = pk(bflo(v[q]) * kd, bfhi(v[q]) * kd);
        *(LAS u32x4*)(lds + off_b(row, ch)) = o;
    }
#pragma unroll
    for (int k = 0; k < 8; ++k) {
        const int idx = tid + 512 * k, row = idx >> 5, ch = idx & 31;
        const u32x4 v = *(const u32x4*)(hb0 + (size_t)row * DIN + C_VR + hh * 256 + ch * 8);
        *(LAS u32x4*)(lds + 32768 + (ch >> 4) * 32768 + off_b(row, ch & 15)) = v;
    }
    __syncthreads();
    const int blk = (lane >> 4) & 1, q4 = (lane & 15) >> 2, p4 = lane & 3;
    LAS unsigned char* vimg = lds + 32768 + (w >> 2) * 32768;
    const int cv = w & 3;
    f32x16 acc[4];
#pragma unroll
    for (int db = 0; db < 4; ++db) acc[db] = zero16();
    LAS unsigned char* vrd[2]; LAS unsigned char* krd[4][2];
#pragma unroll
    for (int t = 0; t < 2; ++t) { const unsigned f_ = ((q4 & 3) << 2) | ((2 * h2 + t) & 3); const unsigned rb = 256 * (8 * h2 + q4 + 4 * t) + 8 * (p4 & 1);
        vrd[t] = vimg + rb + 16 * ((unsigned)(4 * cv + 2 * blk + (p4 >> 1)) ^ f_);
#pragma unroll
        for (int db = 0; db < 4; ++db) krd[db][t] = lds + rb + 16 * ((unsigned)(4 * db + 2 * blk + (p4 >> 1)) ^ f_); }
#pragma unroll
    for (int ks = 0; ks < 8; ++ks) {
        const bf16x8 vf = tr2(vrd[0] + 4096 * ks, vrd[1] + 4096 * ks);
#pragma unroll
        for (int db = 0; db < 4; ++db) {
            const bf16x8 kf = tr2(krd[db][0] + 4096 * ks, krd[db][1] + 4096 * ks);
            acc[db] = __builtin_amdgcn_mfma_f32_32x32x16_bf16(vf, kf, acc[db], 0, 0, 0);
        }
    }
    float* U = p.UT + (size_t)item * 32768;
#pragma unroll
    for (int db = 0; db < 4; ++db)
#pragma unroll
        for (int rg = 0; rg < 16; ++rg) U[(32 * w + (rg & 3) + 8 * (rg >> 2) + 4 * h2) * 128 + 32 * db + r] = acc[db][rg];
    __syncthreads();
}

__device__ __forceinline__ void ret_sample_item(const Params& p, LAS unsigned char* lds, int item) {
    int tid_ = threadIdx.x; asm volatile("" : "+v"(tid_));
    const int tid = tid_, lane = tid & 63, w = __builtin_amdgcn_readfirstlane(tid >> 6);
    const int hh = item & 3, b = item >> 2;
    LAS float* qs = (LAS float*)lds; LAS float* ks = qs + 1024; LAS float* vs = ks + 1024; LAS float* att = vs + 2048; LAS float* red = att + 64;
    const int tok0 = NP + b * 8;
    const float lg = lg2gamma(hh);
    for (int idx = tid; idx < 1024; idx += 512) { const int i = idx >> 7, dd = idx & 127; const bf16_t* rp = p.hb + (size_t)(tok0 + i) * DIN + hh * 128 + dd; qs[idx] = bf2f(rp[C_QR]); ks[idx] = bf2f(rp[C_KR]); }
    for (int idx = tid; idx < 2048; idx += 512) { const int i = idx >> 8, e = idx & 255; vs[idx] = bf2f(p.hb[(size_t)(tok0 + i) * DIN + C_VR + hh * 256 + e]); }
    __syncthreads();
    if (tid < 64) { const int i = tid >> 3, j = tid & 7; float a = 0.f; for (int dd = 0; dd < 128; ++dd) a += qs[i * 128 + dd] * ks[j * 128 + dd]; att[tid] = j <= i ? a * fexp2(lg * (float)(i - j)) : 0.f; }
    __syncthreads();
    const int e = tid & 255, dh = tid >> 8;
    const size_t sbase = ((size_t)(b * 4 + hh) * 128) * 256;
    const float* S0 = p.state + sbase; float* Sn = p.out + O_RETS + sbase;
    float o[8], vv[8];
#pragma unroll
    for (int i = 0; i < 8; ++i) { o[i] = 0.f; vv[i] = vs[i * 256 + e] * fexp2(lg * (float)(7 - i)); }
    const float g8 = fexp2(lg * 8.0f);
#pragma unroll 4
    for (int dd = 0; dd < 64; ++dd) {
        const int d = dh * 64 + dd; const float s0 = S0[d * 256 + e];
        float sn = g8 * s0;
#pragma unroll
        for (int j = 0; j < 8; ++j) sn += ks[j * 128 + d] * vv[j];
        Sn[d * 256 + e] = sn;
#pragma unroll
        for (int i = 0; i < 8; ++i) o[i] += qs[i * 128 + d] * s0;
    }
#pragma unroll
    for (int i = 0; i < 8; ++i) {
        float x = o[i] * fexp2(lg * (float)(i + 1));
        if (dh == 0) {
#pragma unroll
            for (int j = 0; j < 8; ++j) if (j <= i) x += att[i * 8 + j] * vs[j * 256 + e];
        }
        red[(dh * 8 + i) * 256 + e] = x;
    }
    __syncthreads();
    {
        const int i = w; float x[4]; float s = 0.f;
#pragma unroll
        for (int k = 0; k < 4; ++k) { x[k] = red[i * 256 + lane + 64 * k] + red[(8 + i) * 256 + lane + 64 * k]; s += x[k]; }
        const float mu = wave_sum(s) * (1.0f / 256.0f);
        float q = 0.f;
#pragma unroll
        for (int k = 0; k < 4; ++k) { x[k] -= mu; q += x[k] * x[k]; }
        const float rstd = rsqrtf(wave_sum(q) * (1.0f / 256.0f) + 1e-5f);
#pragma unroll
        for (int k = 0; k < 4; ++k) {
            const int ee = hh * 256 + lane + 64 * k;
            const float z = bf2f(p.hb[(size_t)(tok0 + i) * DIN + C_ZR + ee]);
            const unsigned u = pk(x[k] * rstd * p.gn_g[ee] * z, 0.f);
            p.bin[(size_t)(tok0 + i) * 1024 + ee] = (bf16_t)(u & 0xffffu);
        }
    }
    __syncthreads();
}

__device__ __forceinline__ void phase2(const Params& p, LAS unsigned char* lds) {
    const int nb = gridDim.x, bid = blockIdx.x, w = threadIdx.x >> 6;
    for (int it = bid; it < 768; it += nb) attn_prompt_item(p, lds, it);
    __builtin_amdgcn_sched_barrier(0);
    for (int it = bid; it < 512; it += nb) ret_u_item(p, lds, it);
    __builtin_amdgcn_sched_barrier(0);
    for (int it = nb - 1 - bid; it < 128; it += nb) ret_sample_item(p, lds, it);
    __builtin_amdgcn_sched_barrier(0);
    __syncthreads();
    LAS float* wl = (LAS float*)lds + w * 320;
#ifndef NO_D
    for (int task = bid * 8 + w; task < 3072; task += nb * 8) attn_sample_task(p, wl, task);
#endif
}

__device__ __forceinline__ void phase3(const Params& p) {
    const size_t gtid = (size_t)blockIdx.x * 512 + threadIdx.x, gstride = (size_t)gridDim.x * 512;
    for (size_t v = gtid; v < 16 * 8192; v += gstride) {
        const int bh = (int)(v >> 13), b = bh >> 2, hh = bh & 3, el = (int)(v & 8191) * 4, e = el >> 7, d = el & 127;
        const float cd = fexp2(lg2gamma(hh) * 128.0f);
        f32x4 s = {0.f, 0.f, 0.f, 0.f};
#pragma unroll 8
        for (int c = 0; c < 32; ++c) {
            const size_t off = (size_t)((b * 32 + c) * 4 + hh) * 32768 + el;
            u32x2 o = {pk(s[0], s[1]), pk(s[2], s[3])};
            *(u32x2*)(p.ST + off) = o;
            const f32x4 u = *(const f32x4*)(p.UT + off);
            s = s * cd + u;
        }
        float* rp = p.out + O_RETP + ((size_t)(b * 4 + hh) * 128 + d) * 256 + e;
        rp[0] = s[0]; rp[256] = s[1]; rp[512] = s[2]; rp[768] = s[3];
    }
    for (size_t v = gtid; v < (size_t)NTOK * 64; v += gstride) {
        const size_t tok = v >> 6; const int d8 = (int)(v & 63) * 8, hh = d8 >> 7;
        const float l0 = p.lse[(0 * (size_t)NTOK + tok) * 4 + hh], l1 = p.lse[(1 * (size_t)NTOK + tok) * 4 + hh], l2 = p.lse[(2 * (size_t)NTOK + tok) * 4 + hh];
        const float mx = fmaxf(l0, fmaxf(l1, l2));
        float w0 = fexp2((l0 - mx) * LOG2E), w1 = fexp2((l1 - mx) * LOG2E), w2 = fexp2((l2 - mx) * LOG2E);
        const float rs = 1.0f / (w0 + w1 + w2); w0 *= rs; w1 *= rs; w2 *= rs;
        const u32x4 a0 = *(const u32x4*)(p.og + (0 * (size_t)NTOK + tok) * 512 + d8), a1 = *(const u32x4*)(p.og + (1 * (size_t)NTOK + tok) * 512 + d8), a2 = *(const u32x4*)(p.og + (2 * (size_t)NTOK + tok) * 512 + d8);
        const u32x4 z = *(const u32x4*)(p.hb + tok * DIN + C_ZA + d8);
        u32x4 o;
#pragma unroll
        for (int q = 0; q < 4; ++q)
            o[q] = pk(bflo(z[q]) * (w0 * bflo(a0[q]) + w1 * bflo(a1[q]) + w2 * bflo(a2[q])), bfhi(z[q]) * (w0 * bfhi(a0[q]) + w1 * bfhi(a1[q]) + w2 * bfhi(a2[q])));
        *(u32x4*)(p.ain + tok * 512 + d8) = o;
    }
}

__device__ __forceinline__ void ret_out_item(const Params& p, LAS unsigned char* lds, int item) {
    int tid_ = threadIdx.x; asm volatile("" : "+v"(tid_));
    const int tid = tid_, lane = tid & 63, w = __builtin_amdgcn_readfirstlane(tid >> 6), r = lane & 31, h2 = lane >> 5;
    const int hh = item & 3, c = (item >> 2) & 31, b = item >> 7;
    const int tok0 = b * 4096 + c * 128;
    const float lg = lg2gamma(hh);
    const bf16_t* hb0 = p.hb + (size_t)tok0 * DIN;
    LAS unsigned char* Qi = lds; LAS unsigned char* Ki = lds + 32768; LAS unsigned char* Vi = lds + 65536;
    LAS float* red = (LAS float*)(lds + 131072);
#pragma unroll
    for (int k = 0; k < 4; ++k) {
        const int idx = tid + 512 * k, row = idx >> 4, ch = idx & 15;
        const bf16_t* rp = hb0 + (size_t)row * DIN + hh * 128 + ch * 8;
        *(LAS u32x4*)(Qi + off_b(row, ch)) = *(const u32x4*)(rp + C_QR);
        *(LAS u32x4*)(Ki + off_b(row, ch)) = *(const u32x4*)(rp + C_KR);
    }
#pragma unroll
    for (int k = 0; k < 8; ++k) {
        const int idx = tid + 512 * k, row = idx >> 5, ch = idx & 31;
        *(LAS u32x4*)(Vi + (ch >> 4) * 32768 + off_b(row, ch & 15)) = *(const u32x4*)(hb0 + (size_t)row * DIN + C_VR + hh * 256 + ch * 8);
    }
    __syncthreads();
    const int iq = w & 3, eh = w >> 2, i = 32 * iq + r;
    bf16x8 qf[8];
    unsigned rrd[8];
    { const unsigned fr_ = ((r & 3) << 2) | ((r >> 2) & 3);
#pragma unroll
      for (int s = 0; s < 8; ++s) rrd[s] = 256 * r + 16 * ((unsigned)(2 * s + h2) ^ fr_); }
#pragma unroll
    for (int s = 0; s < 8; ++s) qf[s] = *(const LAS bf16x8*)(Qi + 8192 * iq + rrd[s]);
    bf16x8 pf[4][2];
#pragma unroll
    for (int jt = 0; jt < 4; ++jt) {
        if (jt <= iq) {
            f32x16 a = zero16();
#pragma unroll
            for (int s = 0; s < 8; ++s) {
                const bf16x8 kf = *(const LAS bf16x8*)(Ki + rrd[s] + 8192 * jt);
                a = __builtin_amdgcn_mfma_f32_32x32x16_bf16(kf, qf[s], a, 0, 0, 0);
            }
#pragma unroll
            for (int rg = 0; rg < 16; ++rg) { const int j = 32 * jt + (rg & 3) + 8 * (rg >> 2) + 4 * h2, df = i - j; a[rg] = df >= 0 ? a[rg] * fexp2(lg * (float)df) : 0.f; }
#pragma unroll
            for (int s2 = 0; s2 < 2; ++s2) pf[jt][s2] = pack8(a[8 * s2], a[8 * s2 + 1], a[8 * s2 + 2], a[8 * s2 + 3], a[8 * s2 + 4], a[8 * s2 + 5], a[8 * s2 + 6], a[8 * s2 + 7]);
        } else { pf[jt][0] = (bf16x8){0, 0, 0, 0, 0, 0, 0, 0}; pf[jt][1] = pf[jt][0]; }
    }
    __builtin_amdgcn_sched_barrier(0);
    const bf16_t* STp = p.ST + (size_t)item * 32768;
    f32x16 oacc[4];
    const float qdec = fexp2(lg * (float)(i + 1));
#pragma unroll
    for (int eb = 0; eb < 4; ++eb) {
        oacc[eb] = zero16();
        const bf16_t* sr = STp + (size_t)(128 * eh + 32 * eb + r) * 128 + 8 * h2;
#pragma unroll
        for (int s = 0; s < 8; ++s) {
            const bf16x8 sf = *(const bf16x8*)(sr + 16 * s);
            oacc[eb] = __builtin_amdgcn_mfma_f32_32x32x16_bf16(sf, qf[s], oacc[eb], 0, 0, 0);
        }
#pragma unroll
        for (int rg = 0; rg < 16; ++rg) oacc[eb][rg] *= qdec;
        __builtin_amdgcn_sched_barrier(0);
    }
    const int blk = (lane >> 4) & 1, q4 = (lane & 15) >> 2, p4 = lane & 3;
    LAS unsigned char* vimg = Vi + eh * 32768;
    LAS unsigned char* vrd[4][2];
#pragma unroll
    for (int eb = 0; eb < 4; ++eb)
#pragma unroll
        for (int t = 0; t < 2; ++t) { const unsigned f_ = ((q4 & 3) << 2) | ((h2 + 2 * t) & 3);
            vrd[eb][t] = vimg + 256 * (4 * h2 + q4 + 8 * t) + 16 * ((unsigned)(4 * eb + 2 * blk + (p4 >> 1)) ^ f_) + 8 * (p4 & 1); }
#pragma unroll
    for (int jt = 0; jt < 4; ++jt) {
        if (jt <= iq) {
#pragma unroll
            for (int eb = 0; eb < 4; ++eb)
#pragma unroll
                for (int s2 = 0; s2 < 2; ++s2) {
                    const bf16x8 vf = tr2(vrd[eb][0] + 256 * (32 * jt + 16 * s2), vrd[eb][1] + 256 * (32 * jt + 16 * s2));
                    oacc[eb] = __builtin_amdgcn_mfma_f32_32x32x16_bf16(vf, pf[jt][s2], oacc[eb], 0, 0, 0);
                }
        }
    }
    __builtin_amdgcn_sched_barrier(0);
    float s = 0.f;
#pragma unroll
    for (int eb = 0; eb < 4; ++eb)
#pragma unroll
        for (int rg = 0; rg < 16; ++rg) s += oacc[eb][rg];
    s += __shfl_xor(s, 32);
    if (h2 == 0) red[i * 2 + eh] = s;
    __syncthreads();
    const float mu = (red[i * 2] + red[i * 2 + 1]) * (1.0f / 256.0f);
    float qv = 0.f;
#pragma unroll
    for (int eb = 0; eb < 4; ++eb)
#pragma unroll
        for (int rg = 0; rg < 16; ++rg) { oacc[eb][rg] -= mu; qv += oacc[eb][rg] * oacc[eb][rg]; }
    qv += __shfl_xor(qv, 32);
    if (h2 == 0) red[256 + i * 2 + eh] = qv;
    __syncthreads();
    const float rstd = rsqrtf((red[256 + i * 2] + red[256 + i * 2 + 1]) * (1.0f / 256.0f) + 1e-5f);
    const size_t tok = (size_t)tok0 + i;
#pragma unroll
    for (int eb = 0; eb < 4; ++eb)
#pragma unroll
        for (int i4 = 0; i4 < 4; ++i4) {
            const int e0 = hh * 256 + 128 * eh + 32 * eb + 8 * i4 + 4 * h2;
            const f32x4 gn = *(const f32x4*)(p.gn_g + e0);
            const u32x2 z = *(const u32x2*)(p.hb + tok * DIN + C_ZR + e0);
            u32x2 o = {pk(oacc[eb][4 * i4] * rstd * gn[0] * bflo(z[0]), oacc[eb][4 * i4 + 1] * rstd * gn[1] * bfhi(z[0])),
                       pk(oacc[eb][4 * i4 + 2] * rstd * gn[2] * bflo(z[1]), oacc[eb][4 * i4 + 3] * rstd * gn[3] * bfhi(z[1]))};
            *(u32x2*)(p.bin + tok * 1024 + e0) = o;
        }
    __syncthreads();
}
__device__ __forceinline__ void phase4(const Params& p, LAS unsigned char* lds) {
    for (int it = blockIdx.x; it < 512; it += gridDim.x) ret_out_item(p, lds, it);
}

struct Epi5a1 {
    static constexpr bool PERM = true, AFTER_DRAIN = false;
    const bf16_t* hb; float* mpart;
    __device__ __forceinline__ void operator()(const f32x4 (&acc)[2][2][4][2], const pg8::Unit& u, int wr, int wc, int fr, int fq) const {
        const int row0 = u.pm * 256 + wr * 64 + fr, colb = u.pn * 256 + wc * 32 + 8 * fq;
#pragma unroll
        for (int ai = 0; ai < 2; ++ai)
#pragma unroll
            for (int m = 0; m < 4; ++m) {
                const size_t row = row0 + ai * 128 + m * 16;
#pragma unroll
                for (int bj = 0; bj < 2; ++bj) {
                    const int col = colb + bj * 128;
                    const u32x4 gt = *(const u32x4*)(hb + row * DIN + C_GA + col);
                    const f32x4 v0 = acc[ai][bj][m][0], v1 = acc[ai][bj][m][1];
                    f32x4 o0 = {v0[0] * bflo(gt[0]), v0[1] * bfhi(gt[0]), v0[2] * bflo(gt[1]), v0[3] * bfhi(gt[1])};
                    f32x4 o1 = {v1[0] * bflo(gt[2]), v1[1] * bfhi(gt[2]), v1[2] * bflo(gt[3]), v1[3] * bfhi(gt[3])};
                    *(f32x4*)(mpart + row * 1024 + col) = o0; *(f32x4*)(mpart + row * 1024 + col + 4) = o1;
                }
            }
    }
};
struct Epi5a2 {
    static constexpr bool PERM = true, AFTER_DRAIN = false;
    const bf16_t* hb; const float* mpart; bf16_t* mb;
    __device__ __forceinline__ void operator()(const f32x4 (&acc)[2][2][4][2], const pg8::Unit& u, int wr, int wc, int fr, int fq) const {
        const int row0 = u.pm * 256 + wr * 64 + fr, colb = u.pn * 256 + wc * 32 + 8 * fq;
#pragma unroll
        for (int ai = 0; ai < 2; ++ai)
#pragma unroll
            for (int m = 0; m < 4; ++m) {
                const size_t row = row0 + ai * 128 + m * 16;
#pragma unroll
                for (int bj = 0; bj < 2; ++bj) {
                    const int col = colb + bj * 128;
                    const u32x4 gt = *(const u32x4*)(hb + row * DIN + C_GB + col);
                    const f32x4 m0 = *(const f32x4*)(mpart + row * 1024 + col), m1 = *(const f32x4*)(mpart + row * 1024 + col + 4);
                    const f32x4 v0 = acc[ai][bj][m][0], v1 = acc[ai][bj][m][1];
                    u32x4 o = {pk(m0[0] + v0[0] * bflo(gt[0]), m0[1] + v0[1] * bfhi(gt[0])), pk(m0[2] + v0[2] * bflo(gt[1]), m0[3] + v0[3] * bfhi(gt[1])),
                               pk(m1[0] + v1[0] * bflo(gt[2]), m1[1] + v1[1] * bfhi(gt[2])), pk(m1[2] + v1[2] * bflo(gt[3]), m1[3] + v1[3] * bfhi(gt[3]))};
                    *(u32x4*)(mb + row * 1024 + col) = o;
                }
            }
    }
};
struct Epi5b {
    static constexpr bool PERM = false, AFTER_DRAIN = false;
    const float *x_p, *x_s; float* out;
    __device__ __forceinline__ void operator()(const f32x4 (&acc)[2][2][4][2], const pg8::Unit& u, int wr, int wc, int fr, int fq) const {
        const int row0 = u.pm * 256 + wr * 64 + fr, col0 = u.pn * 256 + wc * 32 + 4 * fq;
#pragma unroll
        for (int ai = 0; ai < 2; ++ai)
#pragma unroll
            for (int m = 0; m < 4; ++m) {
                const int row = row0 + ai * 128 + m * 16;
                const float* xr = (row < NP ? x_p + (size_t)row * 1024 : x_s + (size_t)(row - NP) * 1024) + col0;
                float* orow = out + (size_t)row * 1024 + col0;
#pragma unroll
                for (int bj = 0; bj < 2; ++bj)
#pragma unroll
                    for (int n = 0; n < 2; ++n) {
                        const f32x4 xv = *(const f32x4*)(xr + bj * 128 + n * 16);
                        *(f32x4*)(orow + bj * 128 + n * 16) = xv * 1.189207115002721f + acc[ai][bj][m][n];
                    }
            }
    }
};
__device__ __forceinline__ void phase5a(const Params& p, LAS unsigned char* lds) {
    pg8::StaticOrder S; S.init(NTOK, DM, (int)gridDim.x, (int)blockIdx.x);
    { pg8::Gemm g{p.ain, p.wpaT, NTOK, DM, 512}; Epi5a1 E{p.hb, p.mpart}; pg8::gemm_phase<Epi5a1, pg8::StaticOrder, false>(lds, g, S, E, nullptr); }
    __syncthreads();
    { pg8::Gemm g{p.bin, p.wpbT, NTOK, DM, 1024}; Epi5a2 E{p.hb, p.mpart, p.mb}; pg8::gemm_phase<Epi5a2, pg8::StaticOrder, false>(lds, g, S, E, nullptr); }
}
__device__ __forceinline__ void phase5b(const Params& p, LAS unsigned char* lds) {
    pg8::StaticOrder S; S.init(NTOK, DM, (int)gridDim.x, (int)blockIdx.x);
    pg8::Gemm g{p.mb, p.woT, NTOK, DM, 1024}; Epi5b E{p.x_p, p.x_s, p.out};
    pg8::gemm_phase<Epi5b, pg8::StaticOrder, false>(lds, g, S, E, nullptr);
}
__device__ __forceinline__ void phase6(const Params& p) {
    const int lane = threadIdx.x & 63, w = threadIdx.x >> 6;
    for (int row = blockIdx.x * 8 + w; row < NTOK; row += gridDim.x * 8) {
        float* rp = p.out + (size_t)row * 1024 + lane * 4;
        f32x4 v[4]; float s = 0.f;
#pragma unroll
        for (int k = 0; k < 4; ++k) { v[k] = *(const f32x4*)(rp + 256 * k); s += v[k][0] + v[k][1] + v[k][2] + v[k][3]; }
        const float mu = wave_sum(s) * (1.0f / 1024.0f);
        float q = 0.f;
#pragma unroll
        for (int k = 0; k < 4; ++k) { v[k] -= mu; q += v[k][0] * v[k][0] + v[k][1] * v[k][1] + v[k][2] * v[k][2] + v[k][3] * v[k][3]; }
        const float rstd = rsqrtf(wave_sum(q) * (1.0f / 1024.0f) + 1e-5f);
#pragma unroll
        for (int k = 0; k < 4; ++k) {
            const f32x4 gg = *(const f32x4*)(p.ln_g + lane * 4 + 256 * k), bb = *(const f32x4*)(p.ln_b + lane * 4 + 256 * k);
            *(f32x4*)(rp + 256 * k) = v[k] * rstd * gg + bb;
        }
    }
}

#ifndef MULTI
#define MULTI 1
#endif
#if MULTI
#define PHASE_KERNEL(name, call) __global__ void __launch_bounds__(512, 2) name(Params p) { extern __shared__ __attribute__((aligned(16))) unsigned char shm[]; LAS unsigned char* lds = (LAS unsigned char*)shm; (void)lds; call; }
PHASE_KERNEL(k_p0, phase_prep(p, lds))
PHASE_KERNEL(k_p1, phase_gemm1(p, lds))
PHASE_KERNEL(k_p2, phase2(p, lds))
PHASE_KERNEL(k_p3, phase3(p))
PHASE_KERNEL(k_p4, phase4(p, lds))
PHASE_KERNEL(k_p5a, phase5a(p, lds))
PHASE_KERNEL(k_p5b, phase5b(p, lds))
PHASE_KERNEL(k_p6, phase6(p))
#else
__global__ void __launch_bounds__(512, 2) mega(Params p) {
    extern __shared__ __attribute__((aligned(16))) unsigned char shm[];
    LAS unsigned char* lds = (LAS unsigned char*)shm;
    cg::grid_group grid = cg::this_grid();
    phase_prep(p, lds); grid.sync();
    phase_gemm1(p, lds); grid.sync();
    phase2(p, lds); grid.sync();
    phase3(p); grid.sync();
    phase4(p, lds); grid.sync();
    phase5a(p, lds); grid.sync();
    phase5b(p, lds); grid.sync();
    phase6(p);
}
#endif

extern "C" void kernel_launch(void* const* d_in, const int* in_sizes, int n_in, void* d_out, int out_size, void* d_ws, size_t ws_size, hipStream_t stream) {
    Params p{};
    p.x_p = (const float*)d_in[0]; p.x_s = (const float*)d_in[1]; p.c0 = (const float*)d_in[2]; p.c1 = (const float*)d_in[3]; p.c2 = (const float*)d_in[4];
    p.state = (const float*)d_in[5]; p.w_in = (const float*)d_in[6]; p.w_pa = (const float*)d_in[7]; p.w_pb = (const float*)d_in[8]; p.w_o = (const float*)d_in[9];
    p.gn_g = (const float*)d_in[10]; p.ln_g = (const float*)d_in[11]; p.ln_b = (const float*)d_in[12];
    p.out = (float*)d_out;
    unsigned char* ws = (unsigned char*)d_ws; size_t off = 0;
    auto carve = [&](size_t bytes) { unsigned char* r = ws + off; off += (bytes + 255) & ~(size_t)255; return r; };
    p.xb = (bf16_t*)carve((size_t)NTOK * DM * 2);
    p.winT = (bf16_t*)carve((size_t)DIN * DM * 2);
    p.wpaT = (bf16_t*)carve((size_t)1024 * 512 * 2);
    p.wpbT = (bf16_t*)carve((size_t)1024 * 1024 * 2);
    p.woT = (bf16_t*)carve((size_t)1024 * 1024 * 2);
    p.hb = (bf16_t*)carve((size_t)NTOK * DIN * 2);
    p.og = (bf16_t*)carve((size_t)3 * NTOK * 512 * 2);
    p.ain = (bf16_t*)carve((size_t)NTOK * 512 * 2);
    p.bin = (bf16_t*)carve((size_t)NTOK * 1024 * 2);
    p.mb = (bf16_t*)carve((size_t)NTOK * 1024 * 2);
    p.ST = (bf16_t*)carve((size_t)512 * 32768 * 2);
    p.lse = (float*)carve((size_t)3 * NTOK * 4 * 4);
    p.UT = (float*)carve((size_t)512 * 32768 * 4);
    p.mpart = (float*)carve((size_t)NTOK * 1024 * 4);
    p.invtab = (float*)carve(256);
    if (off > ws_size) { fprintf(stderr, "kernel_launch: workspace too small: need %zu have %zu\n", off, ws_size); return; }
    for (int i = 0; i < 64; ++i) { const float step = 1.0f / 63.0f; const float x = i == 63 ? 1.0f : (float)i * step; const float pw = (float)pow(10000.0, (double)x); p.inv[i] = 1.0f / pw; }
    static int grid_blocks = 0;
#if MULTI
    if (!grid_blocks) {
        hipFuncSetAttribute((const void*)k_p0, hipFuncAttributeMaxDynamicSharedMemorySize, LDS_BYTES);
        hipFuncSetAttribute((const void*)k_p1, hipFuncAttributeMaxDynamicSharedMemorySize, LDS_BYTES);
        hipFuncSetAttribute((const void*)k_p2, hipFuncAttributeMaxDynamicSharedMemorySize, LDS_BYTES);
        hipFuncSetAttribute((const void*)k_p3, hipFuncAttributeMaxDynamicSharedMemorySize, LDS_BYTES);
        hipFuncSetAttribute((const void*)k_p4, hipFuncAttributeMaxDynamicSharedMemorySize, LDS_BYTES);
        hipFuncSetAttribute((const void*)k_p5a, hipFuncAttributeMaxDynamicSharedMemorySize, LDS_BYTES);
        hipFuncSetAttribute((const void*)k_p5b, hipFuncAttributeMaxDynamicSharedMemorySize, LDS_BYTES);
        hipFuncSetAttribute((const void*)k_p6, hipFuncAttributeMaxDynamicSharedMemorySize, LDS_BYTES);
        grid_blocks = 256;
    }
    k_p0<<<grid_blocks, 512, LDS_BYTES, stream>>>(p);
    k_p1<<<grid_blocks, 512, LDS_BYTES, stream>>>(p);
    k_p2<<<grid_blocks, 512, LDS_BYTES, stream>>>(p);
    k_p3<<<grid_blocks, 512, LDS_BYTES, stream>>>(p);
    k_p4<<<grid_blocks, 512, LDS_BYTES, stream>>>(p);
    k_p5a<<<grid_blocks, 512, LDS_BYTES, stream>>>(p);
    k_p5b<<<grid_blocks, 512, LDS_BYTES, stream>>>(p);
    k_p6<<<grid_blocks, 512, LDS_BYTES, stream>>>(p);
#else
    if (!grid_blocks) {
        int dev = 0, cus = 0, per_cu = 0;
        hipGetDevice(&dev);
        hipDeviceGetAttribute(&cus, hipDeviceAttributeMultiprocessorCount, dev);
        hipFuncSetAttribute((const void*)mega, hipFuncAttributeMaxDynamicSharedMemorySize, LDS_BYTES);
        hipOccupancyMaxActiveBlocksPerMultiprocessor(&per_cu, (const void*)mega, 512, LDS_BYTES);
        if (per_cu < 1) { fprintf(stderr, "kernel_launch: occupancy query says %d blocks/CU\n", per_cu); per_cu = 1; }
        grid_blocks = cus * 1;
    }
    void* args[] = {&p};
    hipError_t e = hipLaunchCooperativeKernel((const void*)mega, dim3(grid_blocks), dim3(512), args, LDS_BYTES, stream);
    if (e != hipSuccess) fprintf(stderr, "cooperative launch failed: %s (grid %d)\n", hipGetErrorString(e), grid_blocks);
#endif
}
```

```cpp
#include <hip/hip_runtime.h>
#include <hip/hip_cooperative_groups.h>
#include <cstdio>
#include <cmath>
namespace cg = cooperative_groups;
#define MULTI 0
#define REP -1
namespace pg8 {
#define PG8_LAS __attribute__((address_space(3)))
typedef unsigned short bf16_t;
typedef short bf16x8 __attribute__((ext_vector_type(8)));
typedef float f32x4 __attribute__((ext_vector_type(4)));
typedef unsigned u32x4 __attribute__((ext_vector_type(4)));
constexpr int BM = 256, BK = 64, HALF = 128, HTB = HALF * BK * 2  , STAGE_BYTES = 8 * HTB, NXCD = 8, WGM = 8;

__host__ __device__ __forceinline__ int lds_byte(int r, int c) { const int st = (r >> 4) * 2 + (c >> 5), rr = r & 15, cc = c & 31, ob = rr * 64 + cc * 2; return st * 1024 + (ob ^ (((ob >> 9) & 1) << 5)); }
__host__ __device__ __forceinline__ void stage_rc(int b, int& R, int& C) { const int st = b / 1024, sb = b % 1024, swz = sb ^ (((sb >> 9) & 1) << 5); R = (st >> 1) * 16 + swz / 64; C = (st & 1) * 32 + (swz % 64) / 2; }
__host__ __device__ __forceinline__ int perm32(int rho) { const int n = rho >> 4, i = rho & 15; return 8 * (i >> 2) + 4 * n + (i & 3); }

struct Unit { int pm, pn; };
struct Gemm { const bf16_t* A; const bf16_t* Bt; int M, N, K; };

struct StaticOrder {
    int nM, nN, nwg, G, c;
    __host__ __device__ void init(int M, int N, int G_, int c_) { nM = M / BM; nN = N / BM; nwg = nM * nN; G = G_; c = c_; }
    __host__ __device__ bool next(int i, Unit& u) const {
        const long L = (long)i * G + c; if (L >= nwg) return false;
        int wgid = (int)L; { const int q = nwg / NXCD, r = nwg % NXCD, xcd = wgid % NXCD, off = wgid / NXCD; wgid = (xcd < r ? xcd * (q + 1) : r * (q + 1) + (xcd - r) * q) + off; }
        const int nig = WGM * nN, gid = wgid / nig, fm = gid * WGM, gsz = (nM - fm) < WGM ? (nM - fm) : WGM;
        u.pm = fm + ((wgid % nig) % gsz); u.pn = (wgid % nig) / gsz; return true;
    }
    __device__ __forceinline__ void a_ready(const Unit&) const {}
    __device__ __forceinline__ void done(const Unit&) const {}
};
__device__ __forceinline__ unsigned cvt_pk_bf16(float lo, float hi) { unsigned r; asm volatile("v_cvt_pk_bf16_f32 %0, %1, %2" : "=v"(r) : "v"(lo), "v"(hi)); return r; }
template <class Epi, class Sched, bool STAMP = false>
__device__ __forceinline__ void gemm_phase(PG8_LAS unsigned char* lds, const Gemm g, const Sched& S, const Epi& E, unsigned long long* stamps) {
    const int tid = threadIdx.x, wid = __builtin_amdgcn_readfirstlane(tid >> 6), lane = tid & 63, wr = wid >> 2, wc = wid & 3, fr = lane & 15, fq = lane >> 4;
    const int K = g.K, nt = K / BK;
    int ts_lo = 0, ts_hi = 0, nts = 0; const unsigned long long rt_entry = STAMP ? (unsigned long long)wall_clock64() : 0ull;
#define PG8_STAMP() do { if (STAMP && wid == 0 && nts < 64) { const unsigned long long _c = (unsigned long long)clock64(); \
        ts_lo = (lane == nts) ? (int)(unsigned)_c : ts_lo; ts_hi = (lane == nts) ? (int)(unsigned)(_c >> 32) : ts_hi; ++nts; } } while (0)
    PG8_STAMP();
    unsigned voffA[2], voffB[2];
#pragma unroll
    for (int i = 0; i < 2; ++i) { int R, C; stage_rc(tid * 16 + i * 8192, R, C); const int Rb = Epi::PERM ? ((R & ~31) + perm32(R & 31)) : R;
        voffA[i] = (unsigned)(R * K + C) * 2u; voffB[i] = (unsigned)(Rb * K + C) * 2u; }
    const size_t kstep = (size_t)(BK * 2);
    const size_t hstep = (size_t)HALF * K * 2;
    const size_t tstep = 2 * hstep;
    const unsigned ldsw = (unsigned)wid * 1024u;
    const int aoff = lds_byte(wr * 64 + fr, fq * 8), boff = lds_byte(wc * 32 + fr, fq * 8);
#define PG8_SA(b, h) (((b) * 2 + (h)) * HTB)
#define PG8_SB(b, h) ((4 + (b) * 2 + (h)) * HTB)
#define PG8_STAGE(bufoff, gbase, voff) do { _Pragma("unroll") for (int _i = 0; _i < 2; ++_i) \
        __builtin_amdgcn_global_load_lds((const unsigned*)((const char*)(gbase) + (voff)[_i]), (PG8_LAS unsigned*)(lds + (bufoff) + ldsw + _i * 8192), 16, 0, 0); } while (0)
#define PG8_LDA(dst, b, h) do { _Pragma("unroll") for (int m = 0; m < 4; ++m) _Pragma("unroll") for (int k = 0; k < 2; ++k) dst[m][k] = *(const PG8_LAS bf16x8*)(lds + PG8_SA(b, h) + aoff + m * 2048 + k * 1024); } while (0)
#define PG8_LDB(dst, b, h) do { _Pragma("unroll") for (int n = 0; n < 2; ++n) _Pragma("unroll") for (int k = 0; k < 2; ++k) dst[n][k] = *(const PG8_LAS bf16x8*)(lds + PG8_SB(b, h) + boff + n * 2048 + k * 1024); } while (0)
#define PG8_MMA(ai, bj, At, Bt) do { __builtin_amdgcn_s_setprio(1); _Pragma("unroll") for (int m = 0; m < 4; ++m) _Pragma("unroll") for (int n = 0; n < 2; ++n) _Pragma("unroll") for (int k = 0; k < 2; ++k) \
        acc[ai][bj][m][n] = __builtin_amdgcn_mfma_f32_16x16x32_bf16(Bt[n][k], At[m][k], acc[ai][bj][m][n], 0, 0, 0); __builtin_amdgcn_s_setprio(0); } while (0)
#define PG8_WAIT_V(n) asm volatile("s_waitcnt vmcnt(" #n ")" ::: "memory")
#define PG8_WAIT_L(n) asm volatile("s_waitcnt lgkmcnt(" #n ")" ::: "memory")
#define PG8_BAR __builtin_amdgcn_s_barrier()
#define PG8_SCHED __builtin_amdgcn_sched_barrier(0)
    Unit cur, nxt; int ui = 0;
    if (!S.next(0, cur)) return;
    f32x4 acc[2][2][4][2];
#pragma unroll
    for (int a = 0; a < 2; ++a)
#pragma unroll
        for (int b = 0; b < 2; ++b)
#pragma unroll
            for (int m = 0; m < 4; ++m)
#pragma unroll
                for (int n = 0; n < 2; ++n) acc[a][b][m][n] = (f32x4){0.f, 0.f, 0.f, 0.f};
    bf16x8 At[4][2], B0[2][2], B1[2][2];
    const char* cA = (const char*)g.A + (size_t)cur.pm * tstep; const char* cB = (const char*)g.Bt + (size_t)cur.pn * tstep;
    S.a_ready(cur);
    PG8_STAGE(PG8_SB(0, 0), cB, voffB); PG8_STAGE(PG8_SA(0, 0), cA, voffA); PG8_STAGE(PG8_SB(0, 1), cB + hstep, voffB); PG8_STAGE(PG8_SA(0, 1), cA + hstep, voffA);
    if (wr == 1) PG8_BAR;
    PG8_WAIT_V(4); PG8_BAR;
    PG8_STAGE(PG8_SB(1, 0), cB + kstep, voffB); PG8_STAGE(PG8_SA(1, 0), cA + kstep, voffA); PG8_STAGE(PG8_SB(1, 1), cB + hstep + kstep, voffB);
    PG8_WAIT_V(6); PG8_BAR;
    PG8_STAMP();
    for (;;) {
        const bool has_next = S.next(ui + 1, nxt);
        const char* nA = has_next ? (const char*)g.A + (size_t)nxt.pm * tstep : cA; const char* nB = has_next ? (const char*)g.Bt + (size_t)nxt.pn * tstep : cB;
        for (int t = 0; t < nt; t += 2) {
            const bool last = (t == nt - 2);
            const char* a1 = cA + (size_t)(t + 1) * kstep;
            const char* a2 = last ? nA : cA + (size_t)(t + 2) * kstep; const char* b2 = last ? nB : cB + (size_t)(t + 2) * kstep;
            const char* a3 = a2 + kstep; const char* b3 = b2 + kstep;
            if (last && has_next) S.a_ready(nxt);
            PG8_LDB(B0, 0, 0); PG8_SCHED; PG8_LDA(At, 0, 0); PG8_STAGE(PG8_SA(1, 1), a1 + hstep, voffA);
            PG8_WAIT_L(8); PG8_BAR; PG8_WAIT_L(0); PG8_MMA(0, 0, At, B0); PG8_BAR; PG8_SCHED;
            PG8_LDB(B1, 0, 1); PG8_STAGE(PG8_SB(0, 0), b2, voffB);
            PG8_BAR; PG8_WAIT_L(0); PG8_MMA(0, 1, At, B1); PG8_BAR;
            PG8_LDA(At, 0, 1); PG8_STAGE(PG8_SA(0, 0), a2, voffA);
            PG8_BAR; PG8_WAIT_L(0); PG8_MMA(1, 0, At, B0); PG8_BAR; PG8_SCHED;
            PG8_STAGE(PG8_SB(0, 1), b2 + hstep, voffB);
            PG8_WAIT_V(6); PG8_BAR; PG8_MMA(1, 1, At, B1); PG8_BAR;
            PG8_LDB(B0, 1, 0); PG8_SCHED; PG8_LDA(At, 1, 0); PG8_STAGE(PG8_SA(0, 1), a2 + hstep, voffA);
            PG8_WAIT_L(8); PG8_BAR; PG8_WAIT_L(0); PG8_MMA(0, 0, At, B0); PG8_BAR; PG8_SCHED;
            PG8_LDB(B1, 1, 1); PG8_STAGE(PG8_SB(1, 0), b3, voffB);
            PG8_BAR; PG8_WAIT_L(0); PG8_MMA(0, 1, At, B1); PG8_BAR;
            PG8_LDA(At, 1, 1); PG8_STAGE(PG8_SA(1, 0), a3, voffA);
            PG8_BAR; PG8_WAIT_L(0); PG8_MMA(1, 0, At, B0); PG8_BAR; PG8_SCHED;
            PG8_STAGE(PG8_SB(1, 1), b3 + hstep, voffB);
            PG8_WAIT_V(6); PG8_BAR; PG8_MMA(1, 1, At, B1); PG8_BAR;
        }
        PG8_STAMP();
        if constexpr (!Epi::AFTER_DRAIN) { E(acc, cur, wr, wc, fr, fq); S.done(cur); }
        PG8_STAMP();
        if (!has_next) break;
#pragma unroll
        for (int a = 0; a < 2; ++a)
#pragma unroll
            for (int b = 0; b < 2; ++b)
#pragma unroll
                for (int m = 0; m < 4; ++m)
#pragma unroll
                    for (int n = 0; n < 2; ++n) acc[a][b][m][n] = (f32x4){0.f, 0.f, 0.f, 0.f};
        cur = nxt; cA = nA; cB = nB; ++ui;
    }
    PG8_WAIT_V(0);
    if (wr == 0) PG8_BAR;
    PG8_BAR;
    if constexpr (Epi::AFTER_DRAIN) { E.fused(acc, cur, wr, wc, fr, fq, lds, wid, lane); S.done(cur); }
    PG8_STAMP();
    if (STAMP && wid == 0) { stamps[lane] = lane < nts ? (((unsigned long long)(unsigned)ts_hi << 32) | (unsigned)ts_lo) : 0ull;
        if (lane == 62) stamps[62] = rt_entry; if (lane == 63) stamps[63] = (unsigned long long)wall_clock64(); }
#undef PG8_STAMP
#undef PG8_SA
#undef PG8_SB
#undef PG8_STAGE
#undef PG8_LDA
#undef PG8_LDB
#undef PG8_MMA
#undef PG8_WAIT_V
#undef PG8_WAIT_L
#undef PG8_BAR
#undef PG8_SCHED
}
}

using pg8::bf16_t; using pg8::bf16x8; using pg8::f32x4; using pg8::u32x4;
typedef float f32x16 __attribute__((ext_vector_type(16)));
typedef short s16x4 __attribute__((ext_vector_type(4)));
typedef unsigned u32x2 __attribute__((ext_vector_type(2)));
typedef float f32x2v __attribute__((ext_vector_type(2)));
#define LAS __attribute__((address_space(3)))

constexpr int NP = 16384, NTOK = 16640, DM = 1024, DIN = 10240;
constexpr int C_QA = 0, C_KA = 1536, C_VA = 3072, C_ZA = 4608, C_QR = 5120, C_KR = 5632, C_VR = 6144, C_ZR = 7168, C_GA = 8192, C_GB = 9216;
constexpr size_t O_YP = 0, O_KVP0 = 17039360, O_KVP1 = 17563648, O_KVP2 = 19660800, O_RETP = 28049408,
                 O_KVS0 = 28573696, O_KVS1 = 32768000, O_KVS2 = 49545216, O_RETS = 116654080, O_END = 120848384;
constexpr int LDS_BYTES = 131072 + 4096;
constexpr float LOG2E = 1.4426950408889634f, LN2 = 0.6931471805599453f;

struct Params {
    const float *x_p, *x_s, *c0, *c1, *c2, *state, *w_in, *w_pa, *w_pb, *w_o, *gn_g, *ln_g, *ln_b;
    float* out;
    bf16_t *xb, *winT, *wpaT, *wpbT, *woT, *hb, *og, *ain, *bin, *mb, *ST;
    float *lse, *UT, *mpart, *invtab;
    unsigned* bar;
    float inv[64];
    unsigned coop_flag, pad_;
};

__device__ __forceinline__ unsigned pk(float lo, float hi) { return pg8::cvt_pk_bf16(lo, hi); }
__device__ __forceinline__ float bflo(unsigned u) { return __uint_as_float(u << 16); }
__device__ __forceinline__ float bfhi(unsigned u) { return __uint_as_float(u & 0xffff0000u); }
__device__ __forceinline__ float bf2f(bf16_t b) { return __uint_as_float(((unsigned)b) << 16); }
__device__ __forceinline__ unsigned off_b(unsigned row, unsigned ch) { return 256u * row + 16u * (ch ^ (((row & 3) << 2) | ((row >> 2) & 3))); }
__device__ __forceinline__ float fexp2(float x) { return __builtin_amdgcn_exp2f(x); }
__device__ __forceinline__ float frcp(float x) { return __builtin_amdgcn_rcpf(x); }
__device__ __forceinline__ float sigm(float x) { return frcp(1.0f + fexp2(-x * LOG2E)); }
__device__ __forceinline__ float lg2gamma(int hh) { return log1pf(-exp2f(-5.0f - (float)hh)) * LOG2E; }
__device__ __forceinline__ bf16x8 tr2(LAS unsigned char* a0, LAS unsigned char* a1) {
    s16x4 x = __builtin_amdgcn_ds_read_tr16_b64_v4i16((LAS s16x4*)a0), y = __builtin_amdgcn_ds_read_tr16_b64_v4i16((LAS s16x4*)a1);
    bf16x8 r; r[0] = x[0]; r[1] = x[1]; r[2] = x[2]; r[3] = x[3]; r[4] = y[0]; r[5] = y[1]; r[6] = y[2]; r[7] = y[3]; return r;
}
__device__ __forceinline__ bf16x8 pack8(float a, float b, float c, float d, float e, float f, float g, float h) {
    u32x4 u = {pk(a, b), pk(c, d), pk(e, f), pk(g, h)}; return __builtin_bit_cast(bf16x8, u);
}
__device__ __forceinline__ f32x16 zero16() { f32x16 z; for (int i = 0; i < 16; ++i) z[i] = 0.f; return z; }
__device__ __forceinline__ float wave_sum(float v) { for (int o = 32; o > 0; o >>= 1) v += __shfl_xor(v, o); return v; }
__device__ __forceinline__ float wave_max(float v) { for (int o = 32; o > 0; o >>= 1) v = fmaxf(v, __shfl_xor(v, o)); return v; }

__device__ __forceinline__ void phase_prep(const Params& p, LAS unsigned char* lds) {
    const int tid = threadIdx.x, nb = gridDim.x, bid = blockIdx.x;
    const size_t gtid = (size_t)bid * 512 + tid, gstride = (size_t)nb * 512;
    if (bid == 0 && tid == 0) {
#pragma unroll
        for (int i = 0; i < 64; ++i) p.invtab[i] = p.inv[i];
    }
    LAS float* tile = (LAS float*)lds;
    for (int t = bid; t < 3200; t += nb) {
        const float* W; bf16_t* Wt; int K, N, kt, nt; bool perm = false;
        if (t < 2560) { W = p.w_in; Wt = p.winT; K = 1024; N = 10240; kt = t & 15; nt = t >> 4; perm = (nt * 64 >= C_QR && nt * 64 < C_VR); }
        else if (t < 2688) { const int t2 = t - 2560; W = p.w_pa; Wt = p.wpaT; K = 512; N = 1024; kt = t2 & 7; nt = t2 >> 3; }
        else if (t < 2944) { const int t2 = t - 2688; W = p.w_pb; Wt = p.wpbT; K = 1024; N = 1024; kt = t2 & 15; nt = t2 >> 4; }
        else { const int t2 = t - 2944; W = p.w_o; Wt = p.woT; K = 1024; N = 1024; kt = t2 & 15; nt = t2 >> 4; }
        {
            const int nn = tid & 63; int n = nt * 64 + nn;
            if (perm) { const int u = n & 127; n = (n & ~127) + (u >> 1) + 64 * (u & 1); }
#pragma unroll
            for (int ps = 0; ps < 8; ++ps) { const int kr = (tid >> 6) + 8 * ps; tile[kr * 65 + nn] = W[(size_t)(kt * 64 + kr) * N + n]; }
        }
        __syncthreads();
        {
            const int n = tid >> 3, k8 = (tid & 7) * 8;
            float v[8];
#pragma unroll
            for (int i = 0; i < 8; ++i) v[i] = tile[(k8 + i) * 65 + n];
            u32x4 o = {pk(v[0], v[1]), pk(v[2], v[3]), pk(v[4], v[5]), pk(v[6], v[7])};
            *(u32x4*)(Wt + (size_t)(nt * 64 + n) * K + kt * 64 + k8) = o;
        }
        __syncthreads();
    }
    for (size_t i = gtid; i < (size_t)NTOK * 128; i += gstride) {
        const size_t e = i * 8;
        const float* src = e < (size_t)NP * DM ? p.x_p + e : p.x_s + (e - (size_t)NP * DM);
        const f32x4 a = *(const f32x4*)src, b = *(const f32x4*)(src + 4);
        u32x4 o = {pk(a[0], a[1]), pk(a[2], a[3]), pk(b[0], b[1]), pk(b[2], b[3])};
        *(u32x4*)(p.xb + e) = o;
    }
#pragma unroll
    for (int g = 0; g < 3; ++g) {
        const int L = 128 << (2 * g);
        const float* src0 = g == 0 ? p.c0 : (g == 1 ? p.c1 : p.c2);
        float* dst0 = p.out + (g == 0 ? O_KVS0 : (g == 1 ? O_KVS1 : O_KVS2));
        const size_t perb = (size_t)(L - 8) * 256, total = perb * 32;
        for (size_t i = gtid; i < total; i += gstride) {
            const size_t b = i / perb, r = i - b * perb;
            const f32x4 v = __builtin_nontemporal_load((const f32x4*)(src0 + ((size_t)b * L + 8) * 1024 + r * 4));
            __builtin_nontemporal_store(v, (f32x4*)(dst0 + (size_t)b * L * 1024 + r * 4));
        }
    }
}

__device__ __forceinline__ void sincos_rev(float ang, float& s, float& c) {
    double rv = (double)ang * 0.15915494309189535; rv -= __builtin_rint(rv);
    const float f = (float)rv; s = __builtin_amdgcn_sinf(f); c = __builtin_amdgcn_cosf(f);
}
struct Epi1 {
    static constexpr bool PERM = true, AFTER_DRAIN = false;
    bf16_t* hb; float* out; const float* invtab;
    __device__ __forceinline__ void operator()(const f32x4 (&acc)[2][2][4][2], const pg8::Unit& u, int wr, int wc, int fr, int fq) const {
        const int pn = u.pn;
        const int row0 = u.pm * 256 + wr * 64 + fr, colb = pn * 256 + wc * 32 + 8 * fq;
        if (pn >= 20 && pn < 24) {
            const float ksc = pn >= 22 ? 0.08838834764831845f : 1.0f;
#pragma unroll
            for (int ai = 0; ai < 2; ++ai)
#pragma unroll
                for (int m = 0; m < 4; ++m) {
                    const int row = row0 + ai * 128 + m * 16; bf16_t* rowp = hb + (size_t)row * DIN;
                    const float pos = (float)(row < NP ? (row & 4095) : 16384 + ((row - NP) & 7));
#pragma unroll
                    for (int bj = 0; bj < 2; ++bj) {
                        const int col = colb + bj * 128, hbase = col & ~127, i0 = (col & 127) >> 1;
                        const f32x4 iv = *(const f32x4*)(invtab + i0);
                        const f32x4 v0 = acc[ai][bj][m][0], v1 = acc[ai][bj][m][1];
                        const float x1[4] = {v0[0], v0[2], v1[0], v1[2]}, x2[4] = {v0[1], v0[3], v1[1], v1[3]};
                        float y1[4], y2[4];
#pragma unroll
                        for (int ii = 0; ii < 4; ++ii) { float s, c; sincos_rev(pos * iv[ii], s, c); y1[ii] = (x1[ii] * c - x2[ii] * s) * ksc; y2[ii] = (x1[ii] * s + x2[ii] * c) * ksc; }
                        u32x2 o1 = {pk(y1[0], y1[1]), pk(y1[2], y1[3])}, o2 = {pk(y2[0], y2[1]), pk(y2[2], y2[3])};
                        *(u32x2*)(rowp + hbase + i0) = o1; *(u32x2*)(rowp + hbase + 64 + i0) = o2;
                    }
                }
            return;
        }
        const int type = pn < 6 ? 0 : (pn < 18 ? 1 : (pn < 20 ? 2 : (pn < 28 ? 4 : (pn < 32 ? 2 : 5))));
#pragma unroll
        for (int ai = 0; ai < 2; ++ai)
#pragma unroll
            for (int m = 0; m < 4; ++m) {
                const int row = row0 + ai * 128 + m * 16; bf16_t* rowp = hb + (size_t)row * DIN;
#pragma unroll
                for (int bj = 0; bj < 2; ++bj) {
                    const int col = colb + bj * 128;
                    f32x4 v0 = acc[ai][bj][m][0], v1 = acc[ai][bj][m][1];
                    if (type == 0) { v0 *= 0.08838834764831845f * LOG2E; v1 *= 0.08838834764831845f * LOG2E; }
                    else if (type == 1) {
                        const int seg = pn - 6, kv = seg >= 6 ? 1 : 0, s6 = seg - 6 * kv, g = s6 >> 1, hh = (s6 & 1) * 2 + bj;
                        const int W = 128 << (2 * g), dcol = wc * 32 + 8 * fq;
                        float* dst = nullptr;
                        if (row < NP) { const int b = row >> 12, t = row & 4095, r = t - (4096 - W);
                            if (r >= 0) dst = out + (g == 0 ? O_KVP0 : (g == 1 ? O_KVP1 : O_KVP2)) + ((size_t)(b * W + r) * 2 + kv) * 512 + hh * 128 + dcol; }
                        else { const int rs = row - NP, b = rs >> 3, t = rs & 7, r = W - 8 + t;
                            dst = out + (g == 0 ? O_KVS0 : (g == 1 ? O_KVS1 : O_KVS2)) + ((size_t)(b * W + r) * 2 + kv) * 512 + hh * 128 + dcol; }
                        if (dst) { *(f32x4*)dst = v0; *(f32x4*)(dst + 4) = v1; }
                    }
                    else if (type == 2) {
#pragma unroll
                        for (int k = 0; k < 4; ++k) { v0[k] *= sigm(v0[k]); v1[k] *= sigm(v1[k]); }
                    }
                    else if (type == 5) {
#pragma unroll
                        for (int k = 0; k < 4; ++k) { v0[k] = sigm(v0[k]); v1[k] = sigm(v1[k]); }
                    }
                    u32x4 o = {pk(v0[0], v0[1]), pk(v0[2], v0[3]), pk(v1[0], v1[1]), pk(v1[2], v1[3])};
                    *(u32x4*)(rowp + col) = o;
                }
            }
    }
};
__device__ __forceinline__ void phase_gemm1(const Params& p, LAS unsigned char* lds) {
    pg8::StaticOrder S; S.init(NTOK, DIN, (int)gridDim.x, (int)blockIdx.x);
    pg8::Gemm g{p.xb, p.winT, NTOK, DIN, DM};
    Epi1 E{p.hb, p.out, p.invtab};
    pg8::gemm_phase<Epi1, pg8::StaticOrder, false>(lds, g, S, E, nullptr);
}

__device__ __forceinline__ void attn_prompt_item(const Params& p, LAS unsigned char* lds, int item) {
    int tid_ = threadIdx.x; asm volatile("" : "+v"(tid_));
    const int tid = tid_, lane = tid & 63, w = __builtin_amdgcn_readfirstlane(tid >> 6), r = lane & 31, h2 = lane >> 5;
    const int g = item >> 8, rem = item & 255, b = rem >> 6, hh = (rem >> 4) & 3, sub = rem & 15;
    const int dl = 2 * g, d = 1 << dl, rho = sub & (d - 1), qb = sub >> dl;
    const int ibase = qb * 256 - 128;
    const bf16_t* hbB = p.hb + (size_t)b * 4096 * DIN;
    const int colK = C_KA + g * 512 + hh * 128, colV = C_VA + g * 512 + hh * 128, colQ = C_QA + g * 512 + hh * 128;
#pragma unroll
    for (int k = 0; k < 12; ++k) {
        const int idx = tid + 512 * k, row = idx >> 4, ch = idx & 15, i = ibase + row;
        u32x4 v = {0u, 0u, 0u, 0u};
        if (i >= 0) v = *(const u32x4*)(hbB + (size_t)(rho + (i << dl)) * DIN + colK + ch * 8);
        *(LAS u32x4*)(lds + off_b(row, ch)) = v;
    }
    __syncthreads();
    const int i0w = qb * 256 + 32 * w;
    const int tokq = rho + ((i0w + r) << dl);
    bf16x8 qf[8];
    { const bf16_t* qrow = hbB + (size_t)tokq * DIN + colQ + 8 * h2;
#pragma unroll
      for (int s = 0; s < 8; ++s) qf[s] = *(const bf16x8*)(qrow + 16 * s); }
    f32x16 sacc[5];
    LAS unsigned char* krd[8];
    { const unsigned fr_ = ((r & 3) << 2) | ((r >> 2) & 3);
#pragma unroll
      for (int s = 0; s < 8; ++s) krd[s] = lds + 256 * (32 * w + r) + 16 * ((unsigned)(2 * s + h2) ^ fr_); }
#pragma unroll
    for (int kt = 0; kt < 5; ++kt) {
        sacc[kt] = zero16();
#pragma unroll
        for (int s = 0; s < 8; ++s) {
            const bf16x8 kf = *(const LAS bf16x8*)(krd[s] + 8192 * kt);
            sacc[kt] = __builtin_amdgcn_mfma_f32_32x32x16_bf16(kf, qf[s], sacc[kt], 0, 0, 0);
        }
    }
    const float slope2 = exp2f(-8.0f * (float)(4 * g + hh + 1) / 12.0f) * LOG2E * (float)d;
    float mx = -3.0e38f;
#pragma unroll
    for (int kt = 0; kt < 5; ++kt)
#pragma unroll
        for (int rg = 0; rg < 16; ++rg) {
            const int kidx = 32 * kt + (rg & 3) + 8 * (rg >> 2) + 4 * h2, ds = r + 128 - kidx;
            const bool valid = ds >= 0 && ds <= 128 && (i0w - 128 + kidx) >= 0;
            const float s = valid ? sacc[kt][rg] - slope2 * (float)ds : -1.0e30f;
            sacc[kt][rg] = s; mx = fmaxf(mx, s);
        }
    mx = fmaxf(mx, __shfl_xor(mx, 32));
    float l = 0.f;
#pragma unroll
    for (int kt = 0; kt < 5; ++kt)
#pragma unroll
        for (int rg = 0; rg < 16; ++rg) { const float pv = fexp2(sacc[kt][rg] - mx); sacc[kt][rg] = pv; l += pv; }
    l += __shfl_xor(l, 32);
    bf16x8 pf[5][2];
#pragma unroll
    for (int kt = 0; kt < 5; ++kt)
#pragma unroll
        for (int s2 = 0; s2 < 2; ++s2)
            pf[kt][s2] = pack8(sacc[kt][8 * s2], sacc[kt][8 * s2 + 1], sacc[kt][8 * s2 + 2], sacc[kt][8 * s2 + 3], sacc[kt][8 * s2 + 4], sacc[kt][8 * s2 + 5], sacc[kt][8 * s2 + 6], sacc[kt][8 * s2 + 7]);
    __syncthreads();
#pragma unroll
    for (int k = 0; k < 12; ++k) {
        const int idx = tid + 512 * k, row = idx >> 4, ch = idx & 15, i = ibase + row;
        u32x4 v = {0u, 0u, 0u, 0u};
        if (i >= 0) v = *(const u32x4*)(hbB + (size_t)(rho + (i << dl)) * DIN + colV + ch * 8);
        *(LAS u32x4*)(lds + off_b(row, ch)) = v;
    }
    __syncthreads();
    const int blk = (lane >> 4) & 1, q4 = (lane & 15) >> 2, p4 = lane & 3;
    f32x16 oacc[4];
    LAS unsigned char* vrd[4][2];
#pragma unroll
    for (int c = 0; c < 4; ++c)
#pragma unroll
        for (int t = 0; t < 2; ++t) { const unsigned f_ = ((q4 & 3) << 2) | ((h2 + 2 * t) & 3);
            vrd[c][t] = lds + 256 * (32 * w + 4 * h2 + q4 + 8 * t) + 16 * ((unsigned)(4 * c + 2 * blk + (p4 >> 1)) ^ f_) + 8 * (p4 & 1); }
#pragma unroll
    for (int c = 0; c < 4; ++c) {
        oacc[c] = zero16();
#pragma unroll
        for (int kt = 0; kt < 5; ++kt)
#pragma unroll
            for (int s2 = 0; s2 < 2; ++s2) {
                const bf16x8 vf = tr2(vrd[c][0] + 256 * (32 * kt + 16 * s2), vrd[c][1] + 256 * (32 * kt + 16 * s2));
                oacc[c] = __builtin_amdgcn_mfma_f32_32x32x16_bf16(vf, pf[kt][s2], oacc[c], 0, 0, 0);
            }
    }
    const float rl = 1.0f / l;
    const int tok = b * 4096 + tokq;
    bf16_t* orow = p.og + ((size_t)g * NTOK + tok) * 512 + hh * 128;
#pragma unroll
    for (int c = 0; c < 4; ++c)
#pragma unroll
        for (int i4 = 0; i4 < 4; ++i4) {
            u32x2 o = {pk(oacc[c][4 * i4] * rl, oacc[c][4 * i4 + 1] * rl), pk(oacc[c][4 * i4 + 2] * rl, oacc[c][4 * i4 + 3] * rl)};
            *(u32x2*)(orow + 32 * c + 8 * i4 + 4 * h2) = o;
        }
    if (h2 == 0) p.lse[((size_t)g * NTOK + tok) * 4 + hh] = (mx + __log2f(l)) * LN2;
    __syncthreads();
}

__device__ __forceinline__ void attn_sample_task(const Params& p, LAS float* wl, int task) {
    int tid_ = threadIdx.x; asm volatile("" : "+v"(tid_));
    const int lane = tid_ & 63;
    const int t = task & 7, g = (task >> 3) % 3, bh = task / 24, hh = bh & 3, b = bh >> 2;
    const int dl = 2 * g, L = 128 << dl;
    const int tok = NP + b * 8 + t;
    const float* cbase = (g == 0 ? p.c0 : (g == 1 ? p.c1 : p.c2)) + (size_t)b * L * 1024 + hh * 128;
    const float* nbase = p.out + (g == 0 ? O_KVS0 : (g == 1 ? O_KVS1 : O_KVS2)) + (size_t)b * L * 1024 + hh * 128;
    { const unsigned u = *(const unsigned*)(p.hb + (size_t)tok * DIN + C_QA + g * 512 + hh * 128 + 2 * lane); wl[2 * lane] = bflo(u); wl[2 * lane + 1] = bfhi(u); }
    __builtin_amdgcn_fence(__ATOMIC_ACQ_REL, "workgroup"); __builtin_amdgcn_wave_barrier();
    const float slope2 = exp2f(-8.0f * (float)(4 * g + hh + 1) / 12.0f) * LOG2E * (float)(1 << dl);
    float sc[3];
#pragma unroll
    for (int rnd = 0; rnd < 3; ++rnd) {
        const int j = lane + 64 * rnd; sc[rnd] = -1.0e30f;
        if (j <= 128) {
            const int pos = L + t - (j << dl);
            const float* kr = pos < L ? cbase + (size_t)pos * 1024 : nbase + (size_t)(pos - 8) * 1024;
            float a = 0.f;
#pragma unroll 16
            for (int k4 = 0; k4 < 32; ++k4) { const f32x4 kv = *(const f32x4*)(kr + 4 * k4); const f32x4 qv = *(const LAS f32x4*)(wl + 4 * k4); a += kv[0] * qv[0] + kv[1] * qv[1] + kv[2] * qv[2] + kv[3] * qv[3]; }
            sc[rnd] = a - slope2 * (float)j;
        }
    }
    const float mx = wave_max(fmaxf(sc[0], fmaxf(sc[1], sc[2])));
    float pe[3]; float l = 0.f;
#pragma unroll
    for (int rnd = 0; rnd < 3; ++rnd) { pe[rnd] = fexp2(sc[rnd] - mx); l += pe[rnd]; }
    l = wave_sum(l);
    const float rl = 1.0f / l;
#pragma unroll
    for (int rnd = 0; rnd < 3; ++rnd) { const int j = lane + 64 * rnd; if (j <= 128) wl[128 + j] = pe[rnd] * rl; }
    __builtin_amdgcn_fence(__ATOMIC_ACQ_REL, "workgroup"); __builtin_amdgcn_wave_barrier();
    float o0 = 0.f, o1 = 0.f;
#pragma unroll 16
    for (int j = 0; j <= 128; ++j) {
        const int pos = L + t - (j << dl);
        const float* vr = (pos < L ? cbase + (size_t)pos * 1024 : nbase + (size_t)(pos - 8) * 1024) + 512;
        const f32x2v v = *(const f32x2v*)(vr + 2 * lane); const float pj = wl[128 + j];
        o0 += pj * v[0]; o1 += pj * v[1];
    }
    *(unsigned*)(p.og + ((size_t)g * NTOK + tok) * 512 + hh * 128 + 2 * lane) = pk(o0, o1);
    if (lane == 0) p.lse[((size_t)g * NTOK + tok) * 4 + hh] = (mx + __log2f(l)) * LN2;
    __builtin_amdgcn_fence(__ATOMIC_ACQ_REL, "workgroup"); __builtin_amdgcn_wave_barrier();
}

__device__ __forceinline__ void ret_u_item(const Params& p, LAS unsigned char* lds, int item) {
    int tid_ = threadIdx.x; asm volatile("" : "+v"(tid_));
    const int tid = tid_, lane = tid & 63, w = __builtin_amdgcn_readfirstlane(tid >> 6), r = lane & 31, h2 = lane >> 5;
    const int hh = item & 3, c = (item >> 2) & 31, b = item >> 7;
    const int tok0 = b * 4096 + c * 128;
    const float lg = lg2gamma(hh);
    const bf16_t* hb0 = p.hb + (size_t)tok0 * DIN;
#pragma unroll
    for (int k = 0; k < 4; ++k) {
        const int idx = tid + 512 * k, row = idx >> 4, ch = idx & 15;
        const u32x4 v = *(const u32x4*)(hb0 + (size_t)row * DIN + C_KR + hh * 128 + ch * 8);
        const float kd = fexp2(lg * (float)(127 - row));
        u32x4 o;
#pragma unroll
        for (int q = 0; q < 4; ++q) o[q] = pk(bflo(v[q]) * kd, bfhi(v[q]) * kd);
        *(LAS u32x4*)(lds + off_b(row, ch)) = o;
    }
#pragma unroll
    for (int k = 0; k < 8; ++k) {
        const int idx = tid + 512 * k, row = idx >> 5, ch = idx & 31;
        const u32x4 v = *(const u32x4*)(hb0 + (size_t)row * DIN + C_VR + hh * 256 + ch * 8);
        *(LAS u32x4*)(lds + 32768 + (ch >> 4) * 32768 + off_b(row, ch & 15)) = v;
    }
    __syncthreads();
    const int blk = (lane >> 4) & 1, q4 = (lane & 15) >> 2, p4 = lane & 3;
    LAS unsigned char* vimg = lds + 32768 + (w >> 2) * 32768;
    const int cv = w & 3;
    f32x16 acc[4];
#pragma unroll
    for (int db = 0; db < 4; ++db) acc[db] = zero16();
    LAS unsigned char* vrd[2]; LAS unsigned char* krd[4][2];
#pragma unroll
    for (int t = 0; t < 2; ++t) { const unsigned f_ = ((q4 & 3) << 2) | ((2 * h2 + t) & 3); const unsigned rb = 256 * (8 * h2 + q4 + 4 * t) + 8 * (p4 & 1);
        vrd[t] = vimg + rb + 16 * ((unsigned)(4 * cv + 2 * blk + (p4 >> 1)) ^ f_);
#pragma unroll
        for (int db = 0; db < 4; ++db) krd[db][t] = lds + rb + 16 * ((unsigned)(4 * db + 2 * blk + (p4 >> 1)) ^ f_); }
#pragma unroll
    for (int ks = 0; ks < 8; ++ks) {
        const bf16x8 vf = tr2(vrd[0] + 4096 * ks, vrd[1] + 4096 * ks);
#pragma unroll
        for (int db = 0; db < 4; ++db) {
            const bf16x8 kf = tr2(krd[db][0] + 4096 * ks, krd[db][1] + 4096 * ks);
            acc[db] = __builtin_amdgcn_mfma_f32_32x32x16_bf16(vf, kf, acc[db], 0, 0, 0);
        }
    }
    float* U = p.UT + (size_t)item * 32768;
#pragma unroll
    for (int db = 0; db < 4; ++db)
#pragma unroll
        for (int rg = 0; rg < 16; ++rg) U[(32 * w + (rg & 3) + 8 * (rg >> 2) + 4 * h2) * 128 + 32 * db + r] = acc[db][rg];
    __syncthreads();
}

__device__ __forceinline__ void ret_sample_item(const Params& p, LAS unsigned char* lds, int item) {
    int tid_ = threadIdx.x; asm volatile("" : "+v"(tid_));
    const int tid = tid_, lane = tid & 63, w = __builtin_amdgcn_readfirstlane(tid >> 6);
    const int hh = item & 3, b = item >> 2;
    LAS float* qs = (LAS float*)lds; LAS float* ks = qs + 1024; LAS float* vs = ks + 1024; LAS float* att = vs + 2048; LAS float* red = att + 64;
    const int tok0 = NP + b * 8;
    const float lg = lg2gamma(hh);
    for (int idx = tid; idx < 1024; idx += 512) { const int i = idx >> 7, dd = idx & 127; const bf16_t* rp = p.hb + (size_t)(tok0 + i) * DIN + hh * 128 + dd; qs[idx] = bf2f(rp[C_QR]); ks[idx] = bf2f(rp[C_KR]); }
    for (int idx = tid; idx < 2048; idx += 512) { const int i = idx >> 8, e = idx & 255; vs[idx] = bf2f(p.hb[(size_t)(tok0 + i) * DIN + C_VR + hh * 256 + e]); }
    __syncthreads();
    if (tid < 64) { const int i = tid >> 3, j = tid & 7; float a = 0.f; for (int dd = 0; dd < 128; ++dd) a += qs[i * 128 + dd] * ks[j * 128 + dd]; att[tid] = j <= i ? a * fexp2(lg * (float)(i - j)) : 0.f; }
    __syncthreads();
    const int e = tid & 255, dh = tid >> 8;
    const size_t sbase = ((size_t)(b * 4 + hh) * 128) * 256;
    const float* S0 = p.state + sbase; float* Sn = p.out + O_RETS + sbase;
    float o[8], vv[8];
#pragma unroll
    for (int i = 0; i < 8; ++i) { o[i] = 0.f; vv[i] = vs[i * 256 + e] * fexp2(lg * (float)(7 - i)); }
    const float g8 = fexp2(lg * 8.0f);
#pragma unroll 4
    for (int dd = 0; dd < 64; ++dd) {
        const int d = dh * 64 + dd; const float s0 = S0[d * 256 + e];
        float sn = g8 * s0;
#pragma unroll
        for (int j = 0; j < 8; ++j) sn += ks[j * 128 + d] * vv[j];
        Sn[d * 256 + e] = sn;
#pragma unroll
        for (int i = 0; i < 8; ++i) o[i] += qs[i * 128 + d] * s0;
    }
#pragma unroll
    for (int i = 0; i < 8; ++i) {
        float x = o[i] * fexp2(lg * (float)(i + 1));
        if (dh == 0) {
#pragma unroll
            for (int j = 0; j < 8; ++j) if (j <= i) x += att[i * 8 + j] * vs[j * 256 + e];
        }
        red[(dh * 8 + i) * 256 + e] = x;
    }
    __syncthreads();
    {
        const int i = w; float x[4]; float s = 0.f;
#pragma unroll
        for (int k = 0; k < 4; ++k) { x[k] = red[i * 256 + lane + 64 * k] + red[(8 + i) * 256 + lane + 64 * k]; s += x[k]; }
        const float mu = wave_sum(s) * (1.0f / 256.0f);
        float q = 0.f;
#pragma unroll
        for (int k = 0; k < 4; ++k) { x[k] -= mu; q += x[k] * x[k]; }
        const float rstd = rsqrtf(wave_sum(q) * (1.0f / 256.0f) + 1e-5f);
#pragma unroll
        for (int k = 0; k < 4; ++k) {
            const int ee = hh * 256 + lane + 64 * k;
            const float z = bf2f(p.hb[(size_t)(tok0 + i) * DIN + C_ZR + ee]);
            const unsigned u = pk(x[k] * rstd * p.gn_g[ee] * z, 0.f);
            p.bin[(size_t)(tok0 + i) * 1024 + ee] = (bf16_t)(u & 0xffffu);
        }
    }
    __syncthreads();
}

__device__ __forceinline__ void phase2(const Params& p, LAS unsigned char* lds) {
    const int nb = gridDim.x, bid = blockIdx.x, w = threadIdx.x >> 6;
    for (int it = bid; it < 768; it += nb) attn_prompt_item(p, lds, it);
    __builtin_amdgcn_sched_barrier(0);
    for (int it = bid; it < 512; it += nb) ret_u_item(p, lds, it);
    __builtin_amdgcn_sched_barrier(0);
    for (int it = nb - 1 - bid; it < 128; it += nb) ret_sample_item(p, lds, it);
    __builtin_amdgcn_sched_barrier(0);
    __syncthreads();
    LAS float* wl = (LAS float*)lds + w * 320;
#ifndef NO_D
    for (int task = bid * 8 + w; task < 3072; task += nb * 8) attn_sample_task(p, wl, task);
#endif
}

__device__ __forceinline__ void phase3(const Params& p) {
    const size_t gtid = (size_t)blockIdx.x * 512 + threadIdx.x, gstride = (size_t)gridDim.x * 512;
    for (size_t v = gtid; v < 16 * 8192; v += gstride) {
        const int bh = (int)(v >> 13), b = bh >> 2, hh = bh & 3, el = (int)(v & 8191) * 4, e = el >> 7, d = el & 127;
        const float cd = fexp2(lg2gamma(hh) * 128.0f);
        f32x4 s = {0.f, 0.f, 0.f, 0.f};
#pragma unroll 8
        for (int c = 0; c < 32; ++c) {
            const size_t off = (size_t)((b * 32 + c) * 4 + hh) * 32768 + el;
            u32x2 o = {pk(s[0], s[1]), pk(s[2], s[3])};
            *(u32x2*)(p.ST + off) = o;
            const f32x4 u = *(const f32x4*)(p.UT + off);
            s = s * cd + u;
        }
        float* rp = p.out + O_RETP + ((size_t)(b * 4 + hh) * 128 + d) * 256 + e;
        rp[0] = s[0]; rp[256] = s[1]; rp[512] = s[2]; rp[768] = s[3];
    }
    for (size_t v = gtid; v < (size_t)NTOK * 64; v += gstride) {
        const size_t tok = v >> 6; const int d8 = (int)(v & 63) * 8, hh = d8 >> 7;
        const float l0 = p.lse[(0 * (size_t)NTOK + tok) * 4 + hh], l1 = p.lse[(1 * (size_t)NTOK + tok) * 4 + hh], l2 = p.lse[(2 * (size_t)NTOK + tok) * 4 + hh];
        const float mx = fmaxf(l0, fmaxf(l1, l2));
        float w0 = fexp2((l0 - mx) * LOG2E), w1 = fexp2((l1 - mx) * LOG2E), w2 = fexp2((l2 - mx) * LOG2E);
        const float rs = 1.0f / (w0 + w1 + w2); w0 *= rs; w1 *= rs; w2 *= rs;
        const u32x4 a0 = *(const u32x4*)(p.og + (0 * (size_t)NTOK + tok) * 512 + d8), a1 = *(const u32x4*)(p.og + (1 * (size_t)NTOK + tok) * 512 + d8), a2 = *(const u32x4*)(p.og + (2 * (size_t)NTOK + tok) * 512 + d8);
        const u32x4 z = *(const u32x4*)(p.hb + tok * DIN + C_ZA + d8);
        u32x4 o;
#pragma unroll
        for (int q = 0; q < 4; ++q)
            o[q] = pk(bflo(z[q]) * (w0 * bflo(a0[q]) + w1 * bflo(a1[q]) + w2 * bflo(a2[q])), bfhi(z[q]) * (w0 * bfhi(a0[q]) + w1 * bfhi(a1[q]) + w2 * bfhi(a2[q])));
        *(u32x4*)(p.ain + tok * 512 + d8) = o;
    }
}

__device__ __forceinline__ void ret_out_item(const Params& p, LAS unsigned char* lds, int item) {
    int tid_ = threadIdx.x; asm volatile("" : "+v"(tid_));
    const int tid = tid_, lane = tid & 63, w = __builtin_amdgcn_readfirstlane(tid >> 6), r = lane & 31, h2 = lane >> 5;
    const int hh = item & 3, c = (item >> 2) & 31, b = item >> 7;
    const int tok0 = b * 4096 + c * 128;
    const float lg = lg2gamma(hh);
    const bf16_t* hb0 = p.hb + (size_t)tok0 * DIN;
    LAS unsigned char* Qi = lds; LAS unsigned char* Ki = lds + 32768; LAS unsigned char* Vi = lds + 65536;
    LAS float* red = (LAS float*)(lds + 131072);
#pragma unroll
    for (int k = 0; k < 4; ++k) {
        const int idx = tid + 512 * k, row = idx >> 4, ch = idx & 15;
        const bf16_t* rp = hb0 + (size_t)row * DIN + hh * 128 + ch * 8;
        *(LAS u32x4*)(Qi + off_b(row, ch)) = *(const u32x4*)(rp + C_QR);
        *(LAS u32x4*)(Ki + off_b(row, ch)) = *(const u32x4*)(rp + C_KR);
    }
#pragma unroll
    for (int k = 0; k < 8; ++k) {
        const int idx = tid + 512 * k, row = idx >> 5, ch = idx & 31;
        *(LAS u32x4*)(Vi + (ch >> 4) * 32768 + off_b(row, ch & 15)) = *(const u32x4*)(hb0 + (size_t)row * DIN + C_VR + hh * 256 + ch * 8);
    }
    __syncthreads();
    const int iq = w & 3, eh = w >> 2, i = 32 * iq + r;
    bf16x8 qf[8];
    unsigned rrd[8];
    { const unsigned fr_ = ((r & 3) << 2) | ((r >> 2) & 3);
#pragma unroll
      for (int s = 0; s < 8; ++s) rrd[s] = 256 * r + 16 * ((unsigned)(2 * s + h2) ^ fr_); }
#pragma unroll
    for (int s = 0; s < 8; ++s) qf[s] = *(const LAS bf16x8*)(Qi + 8192 * iq + rrd[s]);
    bf16x8 pf[4][2];
#pragma unroll
    for (int jt = 0; jt < 4; ++jt) {
        if (jt <= iq) {
            f32x16 a = zero16();
#pragma unroll
            for (int s = 0; s < 8; ++s) {
                const bf16x8 kf = *(const LAS bf16x8*)(Ki + rrd[s] + 8192 * jt);
                a = __builtin_amdgcn_mfma_f32_32x32x16_bf16(kf, qf[s], a, 0, 0, 0);
            }
#pragma unroll
            for (int rg = 0; rg < 16; ++rg) { const int j = 32 * jt + (rg & 3) + 8 * (rg >> 2) + 4 * h2, df = i - j; a[rg] = df >= 0 ? a[rg] * fexp2(lg * (float)df) : 0.f; }
#pragma unroll
            for (int s2 = 0; s2 < 2; ++s2) pf[jt][s2] = pack8(a[8 * s2], a[8 * s2 + 1], a[8 * s2 + 2], a[8 * s2 + 3], a[8 * s2 + 4], a[8 * s2 + 5], a[8 * s2 + 6], a[8 * s2 + 7]);
        } else { pf[jt][0] = (bf16x8){0, 0, 0, 0, 0, 0, 0, 0}; pf[jt][1] = pf[jt][0]; }
    }
    __builtin_amdgcn_sched_barrier(0);
    const bf16_t* STp = p.ST + (size_t)item * 32768;
    f32x16 oacc[4];
    const float qdec = fexp2(lg * (float)(i + 1));
#pragma unroll
    for (int eb = 0; eb < 4; ++eb) {
        oacc[eb] = zero16();
        const bf16_t* sr = STp + (size_t)(128 * eh + 32 * eb + r) * 128 + 8 * h2;
#pragma unroll
        for (int s = 0; s < 8; ++s) {
            const bf16x8 sf = *(const bf16x8*)(sr + 16 * s);
            oacc[eb] = __builtin_amdgcn_mfma_f32_32x32x16_bf16(sf, qf[s], oacc[eb], 0, 0, 0);
        }
#pragma unroll
        for (int rg = 0; rg < 16; ++rg) oacc[eb][rg] *= qdec;
        __builtin_amdgcn_sched_barrier(0);
    }
    const int blk = (lane >> 4) & 1, q4 = (lane & 15) >> 2, p4 = lane & 3;
    LAS unsigned char* vimg = Vi + eh * 32768;
    LAS unsigned char* vrd[4][2];
#pragma unroll
    for (int eb = 0; eb < 4; ++eb)
#pragma unroll
        for (int t = 0; t < 2; ++t) { const unsigned f_ = ((q4 & 3) << 2) | ((h2 + 2 * t) & 3);
            vrd[eb][t] = vimg + 256 * (4 * h2 + q4 + 8 * t) + 16 * ((unsigned)(4 * eb + 2 * blk + (p4 >> 1)) ^ f_) + 8 * (p4 & 1); }
#pragma unroll
    for (int jt = 0; jt < 4; ++jt) {
        if (jt <= iq) {
#pragma unroll
            for (int eb = 0; eb < 4; ++eb)
#pragma unroll
                for (int s2 = 0; s2 < 2; ++s2) {
                    const bf16x8 vf = tr2(vrd[eb][0] + 256 * (32 * jt + 16 * s2), vrd[eb][1] + 256 * (32 * jt + 16 * s2));
                    oacc[eb] = __builtin_amdgcn_mfma_f32_32x32x16_bf16(vf, pf[jt][s2], oacc[eb], 0, 0, 0);
                }
        }
    }
    __builtin_amdgcn_sched_barrier(0);
    float s = 0.f;
#pragma unroll
    for (int eb = 0; eb < 4; ++eb)
#pragma unroll
        for (int rg = 0; rg < 16; ++rg) s += oacc[eb][rg];
    s += __shfl_xor(s, 32);
    if (h2 == 0) red[i * 2 + eh] = s;
    __syncthreads();
    const float mu = (red[i * 2] + red[i * 2 + 1]) * (1.0f / 256.0f);
    float qv = 0.f;
#pragma unroll
    for (int eb = 0; eb < 4; ++eb)
#pragma unroll
        for (int rg = 0; rg < 16; ++rg) { oacc[eb][rg] -= mu; qv += oacc[eb][rg] * oacc[eb][rg]; }
    qv += __shfl_xor(qv, 32);
    if (h2 == 0) red[256 + i * 2 + eh] = qv;
    __syncthreads();
    const float rstd = rsqrtf((red[256 + i * 2] + red[256 + i * 2 + 1]) * (1.0f / 256.0f) + 1e-5f);
    const size_t tok = (size_t)tok0 + i;
#pragma unroll
    for (int eb = 0; eb < 4; ++eb)
#pragma unroll
        for (int i4 = 0; i4 < 4; ++i4) {
            const int e0 = hh * 256 + 128 * eh + 32 * eb + 8 * i4 + 4 * h2;
            const f32x4 gn = *(const f32x4*)(p.gn_g + e0);
            const u32x2 z = *(const u32x2*)(p.hb + tok * DIN + C_ZR + e0);
            u32x2 o = {pk(oacc[eb][4 * i4] * rstd * gn[0] * bflo(z[0]), oacc[eb][4 * i4 + 1] * rstd * gn[1] * bfhi(z[0])),
                       pk(oacc[eb][4 * i4 + 2] * rstd * gn[2] * bflo(z[1]), oacc[eb][4 * i4 + 3] * rstd * gn[3] * bfhi(z[1]))};
            *(u32x2*)(p.bin + tok * 1024 + e0) = o;
        }
    __syncthreads();
}
__device__ __forceinline__ void phase4(const Params& p, LAS unsigned char* lds) {
    for (int it = blockIdx.x; it < 512; it += gridDim.x) ret_out_item(p, lds, it);
}

struct Epi5a1 {
    static constexpr bool PERM = true, AFTER_DRAIN = false;
    const bf16_t* hb; float* mpart;
    __device__ __forceinline__ void operator()(const f32x4 (&acc)[2][2][4][2], const pg8::Unit& u, int wr, int wc, int fr, int fq) const {
        const int row0 = u.pm * 256 + wr * 64 + fr, colb = u.pn * 256 + wc * 32 + 8 * fq;
#pragma unroll
        for (int ai = 0; ai < 2; ++ai)
#pragma unroll
            for (int m = 0; m < 4; ++m) {
                const size_t row = row0 + ai * 128 + m * 16;
#pragma unroll
                for (int bj = 0; bj < 2; ++bj) {
                    const int col = colb + bj * 128;
                    const u32x4 gt = *(const u32x4*)(hb + row * DIN + C_GA + col);
                    const f32x4 v0 = acc[ai][bj][m][0], v1 = acc[ai][bj][m][1];
                    f32x4 o0 = {v0[0] * bflo(gt[0]), v0[1] * bfhi(gt[0]), v0[2] * bflo(gt[1]), v0[3] * bfhi(gt[1])};
                    f32x4 o1 = {v1[0] * bflo(gt[2]), v1[1] * bfhi(gt[2]), v1[2] * bflo(gt[3]), v1[3] * bfhi(gt[3])};
                    *(f32x4*)(mpart + row * 1024 + col) = o0; *(f32x4*)(mpart + row * 1024 + col + 4) = o1;
                }
            }
    }
};
struct Epi5a2 {
    static constexpr bool PERM = true, AFTER_DRAIN = false;
    const bf16_t* hb; const float* mpart; bf16_t* mb;
    __device__ __forceinline__ void operator()(const f32x4 (&acc)[2][2][4][2], const pg8::Unit& u, int wr, int wc, int fr, int fq) const {
        const int row0 = u.pm * 256 + wr * 64 + fr, colb = u.pn * 256 + wc * 32 + 8 * fq;
#pragma unroll
        for (int ai = 0; ai < 2; ++ai)
#pragma unroll
            for (int m = 0; m < 4; ++m) {
                const size_t row = row0 + ai * 128 + m * 16;
#pragma unroll
                for (int bj = 0; bj < 2; ++bj) {
                    const int col = colb + bj * 128;
                    const u32x4 gt = *(const u32x4*)(hb + row * DIN + C_GB + col);
                    const f32x4 m0 = *(const f32x4*)(mpart + row * 1024 + col), m1 = *(const f32x4*)(mpart + row * 1024 + col + 4);
                    const f32x4 v0 = acc[ai][bj][m][0], v1 = acc[ai][bj][m][1];
                    u32x4 o = {pk(m0[0] + v0[0] * bflo(gt[0]), m0[1] + v0[1] * bfhi(gt[0])), pk(m0[2] + v0[2] * bflo(gt[1]), m0[3] + v0[3] * bfhi(gt[1])),
                               pk(m1[0] + v1[0] * bflo(gt[2]), m1[1] + v1[1] * bfhi(gt[2])), pk(m1[2] + v1[2] * bflo(gt[3]), m1[3] + v1[3] * bfhi(gt[3]))};
                    *(u32x4*)(mb + row * 1024 + col) = o;
                }
            }
    }
};
struct Epi5b {
    static constexpr bool PERM = false, AFTER_DRAIN = false;
    const float *x_p, *x_s; float* out;
    __device__ __forceinline__ void operator()(const f32x4 (&acc)[2][2][4][2], const pg8::Unit& u, int wr, int wc, int fr, int fq) const {
        const int row0 = u.pm * 256 + wr * 64 + fr, col0 = u.pn * 256 + wc * 32 + 4 * fq;
#pragma unroll
        for (int ai = 0; ai < 2; ++ai)
#pragma unroll
            for (int m = 0; m < 4; ++m) {
                const int row = row0 + ai * 128 + m * 16;
                const float* xr = (row < NP ? x_p + (size_t)row * 1024 : x_s + (size_t)(row - NP) * 1024) + col0;
                float* orow = out + (size_t)row * 1024 + col0;
#pragma unroll
                for (int bj = 0; bj < 2; ++bj)
#pragma unroll
                    for (int n = 0; n < 2; ++n) {
                        const f32x4 xv = *(const f32x4*)(xr + bj * 128 + n * 16);
                        *(f32x4*)(orow + bj * 128 + n * 16) = xv * 1.189207115002721f + acc[ai][bj][m][n];
                    }
            }
    }
};
__device__ __forceinline__ void phase5a(const Params& p, LAS unsigned char* lds) {
    pg8::StaticOrder S; S.init(NTOK, DM, (int)gridDim.x, (int)blockIdx.x);
    { pg8::Gemm g{p.ain, p.wpaT, NTOK, DM, 512}; Epi5a1 E{p.hb, p.mpart}; pg8::gemm_phase<Epi5a1, pg8::StaticOrder, false>(lds, g, S, E, nullptr); }
    __syncthreads();
    { pg8::Gemm g{p.bin, p.wpbT, NTOK, DM, 1024}; Epi5a2 E{p.hb, p.mpart, p.mb}; pg8::gemm_phase<Epi5a2, pg8::StaticOrder, false>(lds, g, S, E, nullptr); }
}
__device__ __forceinline__ void phase5b(const Params& p, LAS unsigned char* lds) {
    pg8::StaticOrder S; S.init(NTOK, DM, (int)gridDim.x, (int)blockIdx.x);
    pg8::Gemm g{p.mb, p.woT, NTOK, DM, 1024}; Epi5b E{p.x_p, p.x_s, p.out};
    pg8::gemm_phase<Epi5b, pg8::StaticOrder, false>(lds, g, S, E, nullptr);
}
__device__ __forceinline__ void phase6(const Params& p) {
    const int lane = threadIdx.x & 63, w = threadIdx.x >> 6;
    for (int row = blockIdx.x * 8 + w; row < NTOK; row += gridDim.x * 8) {
        float* rp = p.out + (size_t)row * 1024 + lane * 4;
        f32x4 v[4]; float s = 0.f;
#pragma unroll
        for (int k = 0; k < 4; ++k) { v[k] = *(const f32x4*)(rp + 256 * k); s += v[k][0] + v[k][1] + v[k][2] + v[k][3]; }
        const float mu = wave_sum(s) * (1.0f / 1024.0f);
        float q = 0.f;
#pragma unroll
        for (int k = 0; k < 4; ++k) { v[k] -= mu; q += v[k][0] * v[k][0] + v[k][1] * v[k][1] + v[k][2] * v[k][2] + v[k][3] * v[k][3]; }
        const float rstd = rsqrtf(wave_sum(q) * (1.0f / 1024.0f) + 1e-5f);
#pragma unroll
        for (int k = 0; k < 4; ++k) {
            const f32x4 gg = *(const f32x4*)(p.ln_g + lane * 4 + 256 * k), bb = *(const f32x4*)(p.ln_b + lane * 4 + 256 * k);
            *(f32x4*)(rp + 256 * k) = v[k] * rstd * gg + bb;
        }
    }
}


#define XB_TMO      128
#define XB_XCNT(j)  (256  + 64 * (j))
#define XB_XSUB(j)  (1280 + 64 * (j))
#define XB_XGEN(j)  (2304 + 64 * (j))
#define XB_TOP      3328
#define XB_TOPGEN   3392
#define XCD_BAR_WORDS 3456
#define XB_SPIN_CAP (1u << 18)
__device__ __forceinline__ unsigned xb_ld(unsigned* p)              { return __hip_atomic_load(p, __ATOMIC_RELAXED, __HIP_MEMORY_SCOPE_AGENT); }
__device__ __forceinline__ unsigned xb_add(unsigned* p, unsigned v) { return __hip_atomic_fetch_add(p, v, __ATOMIC_RELAXED, __HIP_MEMORY_SCOPE_AGENT); }
__device__ __forceinline__ unsigned xb_xcc_id() { return (unsigned)__builtin_amdgcn_s_getreg((3 << 11) | 20) & 0xFu; }
#define XB_SPIN(cond, bar) do { unsigned _sp = 0; while (cond) { __builtin_amdgcn_s_sleep(1); \
    if ((++_sp & 255u) == 0u) { if (xb_ld(&(bar)[XB_TMO])) break; if (_sp > XB_SPIN_CAP) { atomicAdd(&(bar)[XB_TMO], 1u); break; } } } } while (0)
struct XcdBarrier { unsigned* bar; unsigned x; volatile LAS unsigned* st; };
__device__ __forceinline__ XcdBarrier xcd_barrier_post(unsigned* bar, volatile LAS unsigned* st) {
    XcdBarrier b; b.bar = bar; b.x = xb_xcc_id(); b.st = st;
    if (threadIdx.x == 0) (void)xb_add(&bar[XB_XCNT(b.x)], 1u);
    return b;
}
__device__ __forceinline__ void xcd_barrier_complete(unsigned* bar, unsigned x, unsigned& nloc, unsigned& nx) {
    const unsigned G = gridDim.x * gridDim.y * gridDim.z;
    unsigned sum, cnt, mine, sp = 0u;
    for (;;) {
        sum = 0u; cnt = 0u; mine = 0u;
#pragma unroll
        for (unsigned j = 0; j < 16; ++j) { const unsigned c = xb_ld(&bar[XB_XCNT(j)]); sum += c; cnt += (c > 0u) ? 1u : 0u; mine = (j == x) ? c : mine; }
        if (sum == G) break;
        __builtin_amdgcn_s_sleep(1);
        if ((++sp & 255u) == 0u) { if (xb_ld(&bar[XB_TMO])) break; if (sp > XB_SPIN_CAP) { atomicAdd(&bar[XB_TMO], 1u); break; } }
    }
    nloc = mine > 0u ? mine : 1u; nx = cnt > 0u ? cnt : 1u;
}
__device__ __forceinline__ void xcd_barrier(const XcdBarrier& b) {
    asm volatile("s_waitcnt vmcnt(0)" ::: "memory");
    __syncthreads();
    if (threadIdx.x == 0) {
        unsigned* bar = b.bar;
        __builtin_amdgcn_s_waitcnt(0);
        unsigned nloc = b.st[0], nx = b.st[1];
        if (nloc == 0u) { xcd_barrier_complete(bar, b.x, nloc, nx); b.st[0] = nloc; b.st[1] = nx; }
        const unsigned old = xb_add(&bar[XB_XSUB(b.x)], 1u);
        const unsigned gen = old / nloc;
        if (old + 1u == (gen + 1u) * nloc) {
            __builtin_amdgcn_fence(__ATOMIC_RELEASE, "agent");
            asm volatile("s_waitcnt vmcnt(0)" ::: "memory");
            const unsigned og = xb_add(&bar[XB_TOP], 1u);
            const unsigned tg = og / nx;
            if (og + 1u == (tg + 1u) * nx) xb_add(&bar[XB_TOPGEN], 1u);
            else XB_SPIN(xb_ld(&bar[XB_TOPGEN]) == tg, bar);
            __builtin_amdgcn_fence(__ATOMIC_ACQUIRE, "agent");
            xb_add(&bar[XB_XGEN(b.x)], 1u);
            asm volatile("s_waitcnt vmcnt(0)" ::: "memory");
        } else {
            XB_SPIN(xb_ld(&bar[XB_XGEN(b.x)]) == gen, bar);
            __builtin_amdgcn_fence(__ATOMIC_ACQUIRE, "agent");
            asm volatile("s_waitcnt vmcnt(0)" ::: "memory");
        }
    }
    __syncthreads();
}

#ifndef MULTI
#define MULTI 1
#endif
#if MULTI
#define PHASE_KERNEL(name, call) __global__ void __launch_bounds__(512, 2) name(Params p) { extern __shared__ __attribute__((aligned(16))) unsigned char shm[]; LAS unsigned char* lds = (LAS unsigned char*)shm; (void)lds; call; }
PHASE_KERNEL(k_p0, phase_prep(p, lds))
PHASE_KERNEL(k_p1, phase_gemm1(p, lds))
PHASE_KERNEL(k_p2, phase2(p, lds))
PHASE_KERNEL(k_p3, phase3(p))
PHASE_KERNEL(k_p4, phase4(p, lds))
PHASE_KERNEL(k_p5a, phase5a(p, lds))
PHASE_KERNEL(k_p5b, phase5b(p, lds))
PHASE_KERNEL(k_p6, phase6(p))
#else
__global__ void __launch_bounds__(512, 2) mega(Params p) {
    extern __shared__ __attribute__((aligned(16))) unsigned char shm[];
    LAS unsigned char* lds = (LAS unsigned char*)shm;
    cg::grid_group grid = cg::this_grid();
    if (p.coop_flag) grid.sync();
    volatile LAS unsigned* st = (volatile LAS unsigned*)(lds + 131072 + 4080);
    if (threadIdx.x == 0) { st[0] = 0u; st[1] = 0u; }
    __syncthreads();
    const XcdBarrier xb = xcd_barrier_post(p.bar, st);
#ifndef REP
#define REP -1
#endif
    phase_prep(p, lds); xcd_barrier(xb);
    if (REP == 0) { phase_prep(p, lds); xcd_barrier(xb); }
    phase_gemm1(p, lds); xcd_barrier(xb);
    if (REP == 1) { phase_gemm1(p, lds); xcd_barrier(xb); }
    phase2(p, lds); xcd_barrier(xb);
    if (REP == 2) { phase2(p, lds); xcd_barrier(xb); }
    phase3(p); xcd_barrier(xb);
    if (REP == 3) { phase3(p); xcd_barrier(xb); }
    phase4(p, lds); xcd_barrier(xb);
    if (REP == 4) { phase4(p, lds); xcd_barrier(xb); }
    phase5a(p, lds); xcd_barrier(xb);
    if (REP == 5) { phase5a(p, lds); xcd_barrier(xb); }
    if (REP == 6) { phase5b(p, lds); xcd_barrier(xb); }
    phase5b(p, lds); xcd_barrier(xb);
    if (REP == 7) { for (int k = 0; k < 8; ++k) xcd_barrier(xb); }
    phase6(p);
}
#endif

extern "C" void kernel_launch(void* const* d_in, const int* in_sizes, int n_in, void* d_out, int out_size, void* d_ws, size_t ws_size, hipStream_t stream) {
    Params p{};
    p.x_p = (const float*)d_in[0]; p.x_s = (const float*)d_in[1]; p.c0 = (const float*)d_in[2]; p.c1 = (const float*)d_in[3]; p.c2 = (const float*)d_in[4];
    p.state = (const float*)d_in[5]; p.w_in = (const float*)d_in[6]; p.w_pa = (const float*)d_in[7]; p.w_pb = (const float*)d_in[8]; p.w_o = (const float*)d_in[9];
    p.gn_g = (const float*)d_in[10]; p.ln_g = (const float*)d_in[11]; p.ln_b = (const float*)d_in[12];
    p.out = (float*)d_out;
    unsigned char* ws = (unsigned char*)d_ws; size_t off = 0;
    auto carve = [&](size_t bytes) { unsigned char* r = ws + off; off += (bytes + 255) & ~(size_t)255; return r; };
    p.xb = (bf16_t*)carve((size_t)NTOK * DM * 2);
    p.winT = (bf16_t*)carve((size_t)DIN * DM * 2);
    p.wpaT = (bf16_t*)carve((size_t)1024 * 512 * 2);
    p.wpbT = (bf16_t*)carve((size_t)1024 * 1024 * 2);
    p.woT = (bf16_t*)carve((size_t)1024 * 1024 * 2);
    p.hb = (bf16_t*)carve((size_t)NTOK * DIN * 2);
    p.og = (bf16_t*)carve((size_t)3 * NTOK * 512 * 2);
    p.ain = (bf16_t*)carve((size_t)NTOK * 512 * 2);
    p.bin = (bf16_t*)carve((size_t)NTOK * 1024 * 2);
    p.mb = (bf16_t*)carve((size_t)NTOK * 1024 * 2);
    p.ST = (bf16_t*)carve((size_t)512 * 32768 * 2);
    p.lse = (float*)carve((size_t)3 * NTOK * 4 * 4);
    p.UT = (float*)carve((size_t)512 * 32768 * 4);
    p.mpart = (float*)carve((size_t)NTOK * 1024 * 4);
    p.invtab = (float*)carve(256);
    p.bar = (unsigned*)carve(XCD_BAR_WORDS * 4);
    if (off > ws_size) { fprintf(stderr, "kernel_launch: workspace too small: need %zu have %zu\n", off, ws_size); return; }
    for (int i = 0; i < 64; ++i) { const float step = 1.0f / 63.0f; const float x = i == 63 ? 1.0f : (float)i * step; const float pw = (float)pow(10000.0, (double)x); p.inv[i] = 1.0f / pw; }
    static int grid_blocks = 0;
#if MULTI
    if (!grid_blocks) {
        hipFuncSetAttribute((const void*)k_p0, hipFuncAttributeMaxDynamicSharedMemorySize, LDS_BYTES);
        hipFuncSetAttribute((const void*)k_p1, hipFuncAttributeMaxDynamicSharedMemorySize, LDS_BYTES);
        hipFuncSetAttribute((const void*)k_p2, hipFuncAttributeMaxDynamicSharedMemorySize, LDS_BYTES);
        hipFuncSetAttribute((const void*)k_p3, hipFuncAttributeMaxDynamicSharedMemorySize, LDS_BYTES);
        hipFuncSetAttribute((const void*)k_p4, hipFuncAttributeMaxDynamicSharedMemorySize, LDS_BYTES);
        hipFuncSetAttribute((const void*)k_p5a, hipFuncAttributeMaxDynamicSharedMemorySize, LDS_BYTES);
        hipFuncSetAttribute((const void*)k_p5b, hipFuncAttributeMaxDynamicSharedMemorySize, LDS_BYTES);
        hipFuncSetAttribute((const void*)k_p6, hipFuncAttributeMaxDynamicSharedMemorySize, LDS_BYTES);
        grid_blocks = 256;
    }
    k_p0<<<grid_blocks, 512, LDS_BYTES, stream>>>(p);
    k_p1<<<grid_blocks, 512, LDS_BYTES, stream>>>(p);
    k_p2<<<grid_blocks, 512, LDS_BYTES, stream>>>(p);
    k_p3<<<grid_blocks, 512, LDS_BYTES, stream>>>(p);
    k_p4<<<grid_blocks, 512, LDS_BYTES, stream>>>(p);
    k_p5a<<<grid_blocks, 512, LDS_BYTES, stream>>>(p);
    k_p5b<<<grid_blocks, 512, LDS_BYTES, stream>>>(p);
    k_p6<<<grid_blocks, 512, LDS_BYTES, stream>>>(p);
#else
    if (!grid_blocks) {
        int dev = 0, cus = 0, per_cu = 0;
        hipGetDevice(&dev);
        hipDeviceGetAttribute(&cus, hipDeviceAttributeMultiprocessorCount, dev);
        hipFuncSetAttribute((const void*)mega, hipFuncAttributeMaxDynamicSharedMemorySize, LDS_BYTES);
        hipOccupancyMaxActiveBlocksPerMultiprocessor(&per_cu, (const void*)mega, 512, LDS_BYTES);
        if (per_cu < 1) { fprintf(stderr, "kernel_launch: occupancy query says %d blocks/CU\n", per_cu); per_cu = 1; }
        grid_blocks = cus * 1;
    }
    hipMemsetAsync(p.bar, 0, XCD_BAR_WORDS * 4, stream);
    void* args[] = {&p};
    hipError_t e = hipLaunchCooperativeKernel((const void*)mega, dim3(grid_blocks), dim3(512), args, LDS_BYTES, stream);
    if (e != hipSuccess) fprintf(stderr, "cooperative launch failed: %s (grid %d)\n", hipGetErrorString(e), grid_blocks);
#endif
}
```
